# Optimizing an MI355X kernel written in HIP

```python
import math
import jax
import jax.numpy as jnp
from jax import lax
import numpy as np

D_MODEL = 1024
BATCH = 2
SEQ = 8192
DEPTH = 4

GRID_W = 64
CTX_LEN = 256
Q_BLOCK = 128
ROPE_THETA = 10000.0
NORM_EPS = 1e-6
N_MOD = 6

A_HEADS = 8
A_KV_HEADS = 2
A_DIM = 64
B_HEADS = 8
B_Q_RANK = 256
B_KV_RANK = 128
B_NOPE = 64
B_ROPE = 32
B_V = 64
MLA_SCALE = (B_NOPE + B_ROPE) ** -0.5
C_HEADS = 8
C_DIM = 32
C_V = 64
N_EXPERTS = 32
TOP_K = 4
D_EXPERT = D_MODEL
SWIGLU_ALPHA = 1.702
SWIGLU_LIMIT = 7.0
E_BLOCK = 128

A_WIDTH = A_HEADS * A_DIM
B_WIDTH = B_HEADS * B_V
C_WIDTH = C_HEADS * C_V
IN_SIZES = (A_HEADS * A_DIM, A_KV_HEADS * A_DIM, A_KV_HEADS * A_DIM,
            B_Q_RANK, B_KV_RANK, B_ROPE,
            C_HEADS * 2 * C_DIM, C_HEADS * 2 * C_DIM, C_HEADS * C_V,
            3 * D_MODEL)
IN_COLS = sum(IN_SIZES)
IN_SPLITS = tuple(int(s) for s in np.cumsum(IN_SIZES)[:-1])

kernel_name = 'hybrid_gqa_mla_diffattn_moe_dit_trunk'


def rms_norm(x, gain):
    xf = x.astype(jnp.float32)
    y = xf * lax.rsqrt(jnp.mean(xf * xf, axis=-1, keepdims=True) + NORM_EPS)
    return (y * gain.astype(jnp.float32)).astype(x.dtype)


def modulate(h, shift, scale):
    return h * (1.0 + scale) + shift


def adaln(cond, w_mod, b_mod):
    return jnp.split(jax.nn.silu(cond) @ w_mod + b_mod, N_MOD, axis=-1)


def axial_rope(n_lat, rot_dim):
    n_rows = n_lat // GRID_W
    row = jnp.repeat(jnp.arange(n_rows, dtype=jnp.float32), GRID_W)
    col = jnp.tile(jnp.arange(GRID_W, dtype=jnp.float32), n_rows)
    axis_pairs = rot_dim // 4
    inv_freq = ROPE_THETA ** (-jnp.arange(axis_pairs, dtype=jnp.float32) / axis_pairs)
    ang = jnp.concatenate([row[:, None] * inv_freq, col[:, None] * inv_freq], axis=-1)
    return jnp.cos(ang), jnp.sin(ang)


def apply_rope(x, cos, sin):
    shape = (1, cos.shape[0]) + (1,) * (x.ndim - 3) + (cos.shape[1],)
    cos = cos.reshape(shape)
    sin = sin.reshape(shape)
    x1, x2 = jnp.split(x.astype(jnp.float32), 2, axis=-1)
    return jnp.concatenate([x1 * cos - x2 * sin, x2 * cos + x1 * sin], axis=-1).astype(x.dtype)


def over_query_blocks(fn, *qs):
    bsz, n = qs[0].shape[:2]
    nb = n // Q_BLOCK
    blocks = tuple(jnp.moveaxis(q.reshape((bsz, nb, Q_BLOCK) + q.shape[2:]), 1, 0) for q in qs)
    out = lax.map(lambda args: fn(*args), blocks)
    return jnp.moveaxis(out, 0, 1).reshape((bsz, n) + out.shape[3:])


def apply_direct(fn, *qs):
    return fn(*qs)


def gqa_attend(q, k, v):
    b, nq, h, d = q.shape
    g = k.shape[2]
    qg = q.reshape(b, nq, g, h // g, d)
    s = jnp.einsum('bqgrd,bkgd->bgrqk', qg, k).astype(jnp.float32) * (d ** -0.5)
    p = jax.nn.softmax(s, axis=-1).astype(v.dtype)
    o = jnp.einsum('bgrqk,bkgd->bqgrd', p, v)
    return o.reshape(b, nq, h, v.shape[-1])


def mla_attend(q_nope, q_rope, k_nope, k_rope, v):
    s = (jnp.einsum('bqhd,bkhd->bhqk', q_nope, k_nope)
         + jnp.einsum('bqhd,bkd->bhqk', q_rope, k_rope)).astype(jnp.float32) * MLA_SCALE
    p = jax.nn.softmax(s, axis=-1).astype(v.dtype)
    return jnp.einsum('bhqk,bkhd->bqhd', p, v)


def diff_attend(q, k, v, lam):
    s = jnp.einsum('bqhcd,bkhcd->bhcqk', q, k).astype(jnp.float32) * (q.shape[-1] ** -0.5)
    p = jax.nn.softmax(s, axis=-1)
    w = (p[:, :, 0] - lam * p[:, :, 1]).astype(v.dtype)
    return jnp.einsum('bhqk,bkhd->bqhd', w, v)


def mixer_inputs(h, w_in, a_q_norm, a_k_norm, b_q_a_norm, b_kv_a_norm, b_w_uq, b_w_ukv,
                 b_q_norm, b_k_norm, c_q_norm, c_k_norm, rope_a, rope_b, rope_c):
    bsz, n, _ = h.shape
    (a_q, a_k, a_v, b_cq, b_ckv, b_kr, c_q, c_k, c_v, gates) = jnp.split(h @ w_in, IN_SPLITS, axis=-1)
    a_q = rms_norm(a_q.reshape(bsz, n, A_HEADS, A_DIM), a_q_norm)
    a_k = rms_norm(a_k.reshape(bsz, n, A_KV_HEADS, A_DIM), a_k_norm)
    a_v = a_v.reshape(bsz, n, A_KV_HEADS, A_DIM)
    b_q = (rms_norm(b_cq, b_q_a_norm) @ b_w_uq).reshape(bsz, n, B_HEADS, B_NOPE + B_ROPE)
    b_kv = (rms_norm(b_ckv, b_kv_a_norm) @ b_w_ukv).reshape(bsz, n, B_HEADS, B_NOPE + B_V)
    b_qn = rms_norm(b_q[..., :B_NOPE], b_q_norm[:B_NOPE])
    b_qr = rms_norm(b_q[..., B_NOPE:], b_q_norm[B_NOPE:])
    b_kn = rms_norm(b_kv[..., :B_NOPE], b_k_norm[:B_NOPE])
    b_v = b_kv[..., B_NOPE:]
    b_kr = rms_norm(b_kr, b_k_norm[B_NOPE:])
    c_q = rms_norm(c_q.reshape(bsz, n, C_HEADS, 2, C_DIM), c_q_norm)
    c_k = rms_norm(c_k.reshape(bsz, n, C_HEADS, 2, C_DIM), c_k_norm)
    c_v = c_v.reshape(bsz, n, C_HEADS, C_V)
    if rope_a is not None:
        a_q = apply_rope(a_q, *rope_a)
        a_k = apply_rope(a_k, *rope_a)
        b_qr = apply_rope(b_qr, *rope_b)
        b_kr = apply_rope(b_kr, *rope_b)
        c_q = apply_rope(c_q, *rope_c)
        c_k = apply_rope(c_k, *rope_c)
    return (a_q, b_qn, b_qr, c_q), (a_k, a_v, b_kn, b_kr, b_v, c_k, c_v), gates


def token_mixers(queries, keys_values, lam, blocked):
    a_q, b_qn, b_qr, c_q = queries
    a_k, a_v, b_kn, b_kr, b_v, c_k, c_v = keys_values
    run = over_query_blocks if blocked else apply_direct
    o_a = run(lambda q: gqa_attend(q, a_k, a_v), a_q)
    o_b = run(lambda qn, qr: mla_attend(qn, qr, b_kn, b_kr, b_v), b_qn, b_qr)
    o_c = run(lambda q: diff_attend(q, c_k, c_v, lam), c_q)
    return o_a, o_b, o_c


def merge_branches(o_a, o_b, o_c, gates, c_subln, lam_init, w_o_a, w_o_b, w_o_c, w_out):
    bsz, n = gates.shape[:2]
    o_c = rms_norm(o_c, c_subln) * (1.0 - lam_init)
    g_a, g_b, g_c = jnp.split(jax.nn.sigmoid(gates), 3, axis=-1)
    y = (g_a * (o_a.reshape(bsz, n, A_WIDTH) @ w_o_a)
         + g_b * (o_b.reshape(bsz, n, B_WIDTH) @ w_o_b)
         + g_c * (o_c.reshape(bsz, n, C_WIDTH) @ w_o_c))
    return y @ w_out


def moe_ffn(h, router_w, router_b, w_gu, b_gu, w_down, b_down):
    bsz, n, d = h.shape
    t = h.reshape(-1, d)
    n_tok = t.shape[0]
    n_assign = n_tok * TOP_K
    logits = (t @ router_w + router_b).astype(jnp.float32)
    top_val, top_idx = lax.top_k(logits, TOP_K)
    top_w = jax.nn.softmax(top_val, axis=-1)
    flat_e = top_idx.reshape(-1)
    flat_t = jnp.repeat(jnp.arange(n_tok, dtype=jnp.int32), TOP_K)
    flat_w = top_w.reshape(-1)
    order = jnp.argsort(flat_e)
    e_sorted = flat_e[order]
    counts = jnp.bincount(flat_e, length=N_EXPERTS)
    starts = jnp.cumsum(counts) - counts
    padded = (counts + E_BLOCK - 1) // E_BLOCK * E_BLOCK
    pad_ends = jnp.cumsum(padded)
    pad_starts = pad_ends - padded
    dest = pad_starts[e_sorted] + (jnp.arange(n_assign) - starts[e_sorted])
    n_blocks = (n_assign + N_EXPERTS * (E_BLOCK - 1) + E_BLOCK - 1) // E_BLOCK
    cap = n_blocks * E_BLOCK
    slot_tok = jnp.full((cap,), n_tok, jnp.int32).at[dest].set(flat_t[order])
    slot_w = jnp.zeros((cap,), jnp.float32).at[dest].set(flat_w[order])
    block_e = jnp.minimum(jnp.searchsorted(pad_ends, jnp.arange(n_blocks) * E_BLOCK, side='right'),
                          N_EXPERTS - 1)
    t_pad = jnp.concatenate([t, jnp.zeros((1, d), t.dtype)], axis=0)
    xb = t_pad[slot_tok].reshape(n_blocks, E_BLOCK, d)

    def expert_block(args):
        xblk, e = args
        gu = xblk @ w_gu[e] + b_gu[e]
        glu, lin = jnp.split(gu, 2, axis=-1)
        glu = jnp.minimum(glu, SWIGLU_LIMIT)
        lin = jnp.clip(lin, -SWIGLU_LIMIT, SWIGLU_LIMIT)
        act = glu * jax.nn.sigmoid(SWIGLU_ALPHA * glu) * (lin + 1.0)
        return act @ w_down[e] + b_down[e]

    yb = lax.map(expert_block, (xb, block_e)).reshape(cap, d)
    y = jax.ops.segment_sum(yb * slot_w[:, None].astype(yb.dtype), slot_tok, num_segments=n_tok + 1)[:n_tok]
    return y.reshape(bsz, n, d)


def setup_inputs(seed: int = 0) -> dict:
    key = jax.random.key(seed)
    ks = iter(jax.random.split(key, 40))
    f32 = jnp.float32
    L, D = DEPTH, D_MODEL

    def normal(shape, scale):
        return jax.random.normal(next(ks), shape, f32) * scale

    def gain(n):
        return 1.0 + normal((L, n), 0.02)

    return {
        'x': normal((BATCH, SEQ, D), 1.0),
        'c': normal((BATCH, D), 1.0),
        'ctx': normal((BATCH, CTX_LEN, D), 1.0),
        'c_ctx': normal((D,), 1.0),
        'w_mod': normal((L, D, N_MOD * D), 0.5 * D ** -0.5),
        'b_mod': normal((L, N_MOD * D), 0.01),
        'norm_mix': gain(D),
        'norm_ffn': gain(D),
        'w_in': normal((L, D, IN_COLS), D ** -0.5),
        'a_q_norm': gain(A_DIM),
        'a_k_norm': gain(A_DIM),
        'b_q_a_norm': gain(B_Q_RANK),
        'b_kv_a_norm': gain(B_KV_RANK),
        'b_w_uq': normal((L, B_Q_RANK, B_HEADS * (B_NOPE + B_ROPE)), B_Q_RANK ** -0.5),
        'b_w_ukv': normal((L, B_KV_RANK, B_HEADS * (B_NOPE + B_V)), B_KV_RANK ** -0.5),
        'b_q_norm': gain(B_NOPE + B_ROPE),
        'b_k_norm': gain(B_NOPE + B_ROPE),
        'c_q_norm': gain(C_DIM),
        'c_k_norm': gain(C_DIM),
        'c_lambda': normal((L, 4, C_DIM), 0.1),
        'c_subln': gain(C_V),
        'w_o_a': normal((L, A_WIDTH, D), A_WIDTH ** -0.5),
        'w_o_b': normal((L, B_WIDTH, D), B_WIDTH ** -0.5),
        'w_o_c': normal((L, C_WIDTH, D), C_WIDTH ** -0.5),
        'w_out': normal((L, D, D), D ** -0.5),
        'router_w': normal((L, D, N_EXPERTS), D ** -0.5),
        'router_b': normal((L, N_EXPERTS), 0.01),
        'exp_w_gu': normal((L, N_EXPERTS, D, 2 * D_EXPERT), D ** -0.5),
        'exp_b_gu': normal((L, N_EXPERTS, 2 * D_EXPERT), 0.01),
        'exp_w_down': normal((L, N_EXPERTS, D_EXPERT, D), D_EXPERT ** -0.5),
        'exp_b_down': normal((L, N_EXPERTS, D), 0.01),
    }


def reference(x, c, ctx, c_ctx, w_mod, b_mod, norm_mix, norm_ffn, w_in, a_q_norm, a_k_norm,
              b_q_a_norm, b_kv_a_norm, b_w_uq, b_w_ukv, b_q_norm, b_k_norm, c_q_norm, c_k_norm,
              c_lambda, c_subln, w_o_a, w_o_b, w_o_c, w_out, router_w, router_b,
              exp_w_gu, exp_b_gu, exp_w_down, exp_b_down):
    n_lat = x.shape[1]
    n_ctx = ctx.shape[1]
    rope_a = axial_rope(n_lat, A_DIM)
    rope_b = axial_rope(n_lat, B_ROPE)
    rope_c = axial_rope(n_lat, C_DIM)
    x_lat, x_ctx = x, ctx
    for l in range(DEPTH):
        last = l == DEPTH - 1
        lam_init = 0.8 - 0.6 * math.exp(-0.3 * l)
        lq1, lk1, lq2, lk2 = c_lambda[l].astype(jnp.float32)
        lam = jnp.exp(jnp.sum(lq1 * lk1)) - jnp.exp(jnp.sum(lq2 * lk2)) + lam_init
        sh1, sc1, g1, sh2, sc2, g2 = adaln(c[:, None, :], w_mod[l], b_mod[l])
        csh1, csc1, cg1, csh2, csc2, cg2 = adaln(c_ctx, w_mod[l], b_mod[l])

        def feats(h, ra, rb, rc):
            return mixer_inputs(h, w_in[l], a_q_norm[l], a_k_norm[l], b_q_a_norm[l], b_kv_a_norm[l],
                                b_w_uq[l], b_w_ukv[l], b_q_norm[l], b_k_norm[l], c_q_norm[l],
                                c_k_norm[l], ra, rb, rc)

        def merge(outs, gates):
            return merge_branches(*outs, gates, c_subln[l], lam_init, w_o_a[l], w_o_b[l], w_o_c[l], w_out[l])

        h_lat = modulate(rms_norm(x_lat, norm_mix[l]), sh1, sc1)
        h_ctx = modulate(rms_norm(x_ctx, norm_mix[l]), csh1, csc1)
        q_lat, kv_lat, gate_lat = feats(h_lat, rope_a, rope_b, rope_c)
        q_ctx, kv_ctx, gate_ctx = feats(h_ctx, None, None, None)
        kv_all = tuple(jnp.concatenate([kc, kl], axis=1) for kc, kl in zip(kv_ctx, kv_lat))
        x_lat = x_lat + g1 * merge(token_mixers(q_lat, kv_all, lam, True), gate_lat)
        if not last:
            x_ctx = x_ctx + cg1 * merge(token_mixers(q_ctx, kv_ctx, lam, False), gate_ctx)

        moe = lambda h: moe_ffn(h, router_w[l], router_b[l], exp_w_gu[l], exp_b_gu[l],
                                exp_w_down[l], exp_b_down[l])
        h_lat = modulate(rms_norm(x_lat, norm_ffn[l]), sh2, sc2)
        if last:
            x_lat = x_lat + g2 * moe(h_lat)
        else:
            h_ctx = modulate(rms_norm(x_ctx, norm_ffn[l]), csh2, csc2)
            y = moe(jnp.concatenate([h_ctx, h_lat], axis=1))
            x_ctx = x_ctx + cg2 * y[:, :n_ctx]
            x_lat = x_lat + g2 * y[:, n_ctx:]
    return x_lat
```

```cpp
#include <hip/hip_runtime.h>
#include <cstdio>
#include <cstdint>

#ifndef MK_ONE_LAUNCH
#define MK_ONE_LAUNCH 1
#endif

#define GAS __attribute__((address_space(1)))
#define LAS __attribute__((address_space(3)))
typedef unsigned short bf16;
typedef short bf16x8 __attribute__((ext_vector_type(8)));
typedef short s16x4 __attribute__((ext_vector_type(4)));
typedef float f32x4 __attribute__((ext_vector_type(4)));
typedef float f32x2 __attribute__((ext_vector_type(2)));
typedef float f32x16 __attribute__((ext_vector_type(16)));
typedef unsigned u32x4 __attribute__((ext_vector_type(4)));
typedef unsigned u32x2 __attribute__((ext_vector_type(2)));
typedef float v16f_t __attribute__((ext_vector_type(16)));
typedef unsigned v6u_t __attribute__((ext_vector_type(6)));
typedef GAS unsigned gu32;
typedef int v4i_t __attribute__((ext_vector_type(4)));
typedef int v2i_t __attribute__((ext_vector_type(2)));
typedef int v6i_t __attribute__((ext_vector_type(6)));
typedef int v8i_t __attribute__((ext_vector_type(8)));

constexpr int D = 1024, NB = 2, SEQ = 8192, CTX = 256, TB = SEQ + CTX, T = NB * TB, NL = 4;
constexpr int NIN = 5792, NINP = 5888;
constexpr int CA_Q = 0, CA_K = 512, CA_V = 640, CB_CQ = 768, CB_CKV = 1024, CB_KR = 1152, CC_Q = 1184, CC_K = 1696, CC_V = 2208, CGATE = 2720;
constexpr int NE = 32, CAP = T, MAXSLOT = 75776;
constexpr float NORM_EPS = 1e-6f;
constexpr float LOG2E = 1.4426950408889634f;

enum { I_X = 0, I_C, I_CTX, I_CCTX, I_WMOD, I_BMOD, I_NMIX, I_NFFN, I_WIN, I_AQN, I_AKN, I_BQAN, I_BKVAN, I_WUQ, I_WUKV, I_BQN, I_BKN, I_CQN, I_CKN, I_CLAM, I_CSUB,
       I_WOA, I_WOB, I_WOC, I_WOUT, I_RW, I_RB, I_WGU, I_BGU, I_WDN, I_BDN, N_INPUTS };

constexpr size_t MiB = 1u << 20;
constexpr size_t WS_CTL = 0, CTL_ZERO_BYTES = 1 * MiB;
constexpr size_t WS_MOD = 1 * MiB;
constexpr size_t WS_MISC = 1 * MiB + 512 * 1024;
constexpr size_t WS_ROPE64 = 2 * MiB;
constexpr size_t WS_ROPE32 = 4 * MiB;
constexpr size_t WS_TOK = 6 * MiB;
constexpr size_t WS_WL = 9 * MiB;
constexpr size_t WS_WIN = 16 * MiB;
constexpr size_t WS_WUQ = 62 * MiB;
constexpr size_t WS_WUKV = 64 * MiB;
constexpr size_t WS_WO = 66 * MiB;
constexpr size_t WS_WOUT = 78 * MiB;
constexpr size_t WS_WGU = 96 * MiB;
constexpr size_t WS_WDN = 608 * MiB;
constexpr size_t WS_X = 864 * MiB;
constexpr size_t WS_H = 930 * MiB;
constexpr size_t WS_RAW = 964 * MiB;
constexpr size_t WS_CQN = 1154 * MiB;
constexpr size_t WS_RAW2 = 1168 * MiB;
constexpr size_t WS_QA = 1226 * MiB, WS_KA = 1243 * MiB, WS_QB = 1248 * MiB, WS_KB = 1273 * MiB, WS_QC = 1298 * MiB, WS_KC = 1315 * MiB;
constexpr size_t WS_OA = 1332 * MiB, WS_OB = 1349 * MiB, WS_OC = 1366 * MiB;
constexpr size_t WS_Y = 1383 * MiB;
constexpr size_t WS_YP = 1416 * MiB;
constexpr size_t WS_ACT = 1482 * MiB;
constexpr size_t WS_OUTA = 1630 * MiB;
constexpr size_t WS_H8 = 1762 * MiB;
constexpr size_t WS_Q8A = 1780 * MiB;
constexpr size_t WS_K8A = 1789 * MiB;
constexpr size_t WS_VT8A = 1792 * MiB;
constexpr size_t WS_Q8B = 1795 * MiB;
constexpr size_t WS_K8B = 1812 * MiB;
constexpr size_t WS_VT8B = 1829 * MiB;
constexpr size_t WS_Q8C = 1840 * MiB;
constexpr size_t WS_K8C = 1849 * MiB;
constexpr size_t WS_VT8C = 1858 * MiB;
constexpr size_t WS_END = 1868 * MiB;
constexpr int CW_TMO = 0, CW_BAR = 4096, CW_CNT = 16384;

constexpr int RING_BYTES = 131072;
constexpr int LDSCTL_OFF = RING_BYTES;
constexpr int LDS_BYTES = 147456;
constexpr int LC_BAR = 0, LC_PREF = 256, LC_HIST = 512, LC_BASE = 640, LC_REC = 1024;

constexpr int NWAVES = 8, NTHREADS = 512;

#define LDS_WAIT() asm volatile("s_waitcnt lgkmcnt(0)" ::: "memory")
#define VM_WAIT() asm volatile("s_waitcnt vmcnt(0)" ::: "memory")
#define RLX_AGENT __ATOMIC_RELAXED, __HIP_MEMORY_SCOPE_AGENT

__device__ __forceinline__ unsigned f2bf(float f) { unsigned u = __builtin_bit_cast(unsigned, f); return (u + 0x7fffu + ((u >> 16) & 1u)) >> 16; }
__device__ __forceinline__ unsigned pk2(float lo, float hi) { return f2bf(lo) | (f2bf(hi) << 16); }
__device__ __forceinline__ float bf2f(unsigned short b) { return __builtin_bit_cast(float, ((unsigned)b) << 16); }
__device__ __forceinline__ float bflo(unsigned w) { return __builtin_bit_cast(float, w << 16); }
__device__ __forceinline__ float bfhi(unsigned w) { return __builtin_bit_cast(float, w & 0xffff0000u); }
__device__ __forceinline__ unsigned pk4_fp8(float a, float b, float c, float d) { int w = 0; w = __builtin_amdgcn_cvt_pk_fp8_f32(a, b, w, false); w = __builtin_amdgcn_cvt_pk_fp8_f32(c, d, w, true); return (unsigned)w; }
typedef short v2s_t __attribute__((ext_vector_type(2)));
__device__ __forceinline__ unsigned pk8_fp4x2(const float (&o)[8]) { unsigned w = 0u;
    w = __builtin_amdgcn_cvt_scalef32_pk_fp4_f32(w, o[0], o[1], 0.5f, 0); w = __builtin_amdgcn_cvt_scalef32_pk_fp4_f32(w, o[2], o[3], 0.5f, 1);
    w = __builtin_amdgcn_cvt_scalef32_pk_fp4_f32(w, o[4], o[5], 0.5f, 2); w = __builtin_amdgcn_cvt_scalef32_pk_fp4_f32(w, o[6], o[7], 0.5f, 3); return w; }
__device__ __forceinline__ unsigned pk4_fp8s(float a, float b, float c, float d, float scale) {
    v2s_t w = {0, 0}; w = __builtin_amdgcn_cvt_scalef32_pk_fp8_f32(w, a, b, scale, false); w = __builtin_amdgcn_cvt_scalef32_pk_fp8_f32(w, c, d, scale, true); return __builtin_bit_cast(unsigned, w); }
__device__ __forceinline__ unsigned pk4_bf8(float a, float b, float c, float d) { int w = 0; w = __builtin_amdgcn_cvt_pk_bf8_f32(a, b, w, false); w = __builtin_amdgcn_cvt_pk_bf8_f32(c, d, w, true); return (unsigned)w; }
typedef unsigned short us2_t __attribute__((ext_vector_type(2)));
__device__ __forceinline__ unsigned codes4(float a, float b, float c, float d) {
    const unsigned lo = __builtin_bit_cast(unsigned, __builtin_amdgcn_cvt_pknorm_u16(a, b)), hi = __builtin_bit_cast(unsigned, __builtin_amdgcn_cvt_pknorm_u16(c, d));
    return __builtin_amdgcn_perm(hi, lo, 0x07050301u); }
constexpr float W8_SCALE = 32.0f, W8_INV = 1.0f / 32.0f;
__device__ __forceinline__ int lane_l() { int t = threadIdx.x; asm volatile("" : "+v"(t)); return t & 63; }
__device__ __forceinline__ float shflx(float v, int m) { return __builtin_bit_cast(float, __builtin_amdgcn_ds_bpermute((lane_l() ^ m) << 2, __builtin_bit_cast(int, v))); }
__device__ __forceinline__ int shflx(int v, int m) { return __builtin_amdgcn_ds_bpermute((lane_l() ^ m) << 2, v); }
__device__ __forceinline__ float shfl_from(float v, int src) { return __builtin_bit_cast(float, __builtin_amdgcn_ds_bpermute(src << 2, __builtin_bit_cast(int, v))); }
template <int CTRL> __device__ __forceinline__ float dppf(float v) { return __builtin_bit_cast(float, __builtin_amdgcn_update_dpp(0, __builtin_bit_cast(int, v), CTRL, 0xF, 0xF, true)); }
template <int CTRL> __device__ __forceinline__ unsigned dppu(unsigned v) { return (unsigned)__builtin_amdgcn_update_dpp(0, (int)v, CTRL, 0xF, 0xF, true); }
constexpr int DPP_X1 = 0xB1, DPP_X2 = 0x4E, DPP_HM = 0x141, DPP_RM = 0x140;
__device__ __forceinline__ float row_sum16(float v) { v += dppf<DPP_X1>(v); v += dppf<DPP_X2>(v); v += dppf<DPP_HM>(v); v += dppf<DPP_RM>(v); return v; }
__device__ __forceinline__ float wave_sum(float v) {
    v = row_sum16(v);
    const float s0 = __builtin_bit_cast(float, __builtin_amdgcn_readlane(__builtin_bit_cast(int, v), 0)), s1 = __builtin_bit_cast(float, __builtin_amdgcn_readlane(__builtin_bit_cast(int, v), 16));
    const float s2 = __builtin_bit_cast(float, __builtin_amdgcn_readlane(__builtin_bit_cast(int, v), 32)), s3 = __builtin_bit_cast(float, __builtin_amdgcn_readlane(__builtin_bit_cast(int, v), 48));
    return (s0 + s1) + (s2 + s3);
}
__device__ __forceinline__ float wave_max(float v) {
#pragma unroll
    for (int o = 1; o < 64; o <<= 1) v = fmaxf(v, shflx(v, o));
    return v;
}
__device__ __forceinline__ float sigmoidf_(float x) { return __builtin_amdgcn_rcpf(1.0f + __builtin_amdgcn_exp2f(-x * LOG2E)); }

#define XB_TMO      128
#define XB_XCNT(j)  (256  + 64 * (j))
#define XB_XSUB(j)  (1280 + 64 * (j))
#define XB_XGEN(j)  (2304 + 64 * (j))
#define XB_TOP      3328
#define XB_TOPGEN   3392
#define XCD_BAR_WORDS 3456
#define XB_SPIN_CAP (1u << 22)
__device__ __forceinline__ unsigned xb_ld(unsigned* p)              { return __hip_atomic_load(p, __ATOMIC_RELAXED, __HIP_MEMORY_SCOPE_AGENT); }
__device__ __forceinline__ unsigned xb_add(unsigned* p, unsigned v) { return __hip_atomic_fetch_add(p, v, __ATOMIC_RELAXED, __HIP_MEMORY_SCOPE_AGENT); }
__device__ __forceinline__ unsigned xb_xcc_id() { return (unsigned)__builtin_amdgcn_s_getreg((3 << 11) | 20) & 0xFu; }
#define XB_SPIN(cond, bar) do { unsigned _sp = 0; while (cond) { __builtin_amdgcn_s_sleep(1); \
    if ((++_sp & 255u) == 0u) { if (xb_ld(&(bar)[XB_TMO])) break; if (_sp > XB_SPIN_CAP) { atomicAdd(&(bar)[XB_TMO], 1u); break; } } } } while (0)
struct XcdBarrier { unsigned* bar; unsigned x; volatile LAS unsigned* st; };
__device__ __forceinline__ XcdBarrier xcd_barrier_post(unsigned* bar, volatile LAS unsigned* st) {
    XcdBarrier b; b.bar = bar; b.x = xb_xcc_id(); b.st = st;
    if (threadIdx.x == 0) (void)xb_add(&bar[XB_XCNT(b.x)], 1u);
    return b;
}
__device__ __forceinline__ void xcd_barrier_complete(unsigned* bar, unsigned x, unsigned& nloc, unsigned& nx) {
    const unsigned G = gridDim.x * gridDim.y * gridDim.z;
    unsigned sum, cnt, mine, sp = 0u;
    for (;;) {
        sum = 0u; cnt = 0u; mine = 0u;
#pragma unroll
        for (unsigned j = 0; j < 16; ++j) { const unsigned c = xb_ld(&bar[XB_XCNT(j)]); sum += c; cnt += (c > 0u) ? 1u : 0u; mine = (j == x) ? c : mine; }
        if (sum == G) break;
        __builtin_amdgcn_s_sleep(1);
        if ((++sp & 255u) == 0u) { if (xb_ld(&bar[XB_TMO])) break; if (sp > XB_SPIN_CAP) { atomicAdd(&bar[XB_TMO], 1u); break; } }
    }
    nloc = mine > 0u ? mine : 1u; nx = cnt > 0u ? cnt : 1u;
}
__device__ __forceinline__ void xcd_barrier(const XcdBarrier& b) {
    asm volatile("s_waitcnt vmcnt(0)" ::: "memory");
    __syncthreads();
    if (threadIdx.x == 0) {
        unsigned* bar; { unsigned long long bp_ = (unsigned long long)b.bar; asm volatile("" : "+s"(bp_)); bar = (unsigned*)(GAS unsigned*)bp_; }
        unsigned bx_ = b.x; asm volatile("" : "+s"(bx_));
        __builtin_amdgcn_s_waitcnt(0);
        unsigned nloc = b.st[0], nx = b.st[1];
        if (nloc == 0u) { xcd_barrier_complete(bar, bx_, nloc, nx); b.st[0] = nloc; b.st[1] = nx; }
        const unsigned old = xb_add(&bar[XB_XSUB(bx_)], 1u);
        const unsigned gen = old / nloc;
        if (old + 1u == (gen + 1u) * nloc) {
            __builtin_amdgcn_fence(__ATOMIC_RELEASE, "agent");
            asm volatile("s_waitcnt vmcnt(0)" ::: "memory");
            const unsigned og = xb_add(&bar[XB_TOP], 1u);
            const unsigned tg = og / nx;
            if (og + 1u == (tg + 1u) * nx) xb_add(&bar[XB_TOPGEN], 1u);
            else XB_SPIN(xb_ld(&bar[XB_TOPGEN]) == tg, bar);
            __builtin_amdgcn_fence(__ATOMIC_ACQUIRE, "agent");
            xb_add(&bar[XB_XGEN(bx_)], 1u);
            asm volatile("s_waitcnt vmcnt(0)" ::: "memory");
        } else {
            XB_SPIN(xb_ld(&bar[XB_XGEN(bx_)]) == gen, bar);
            __builtin_amdgcn_fence(__ATOMIC_ACQUIRE, "agent");
            asm volatile("s_waitcnt vmcnt(0)" ::: "memory");
        }
    }
    __syncthreads();
}

namespace gm {
constexpr int GIDX_LDS_OFF = 131072 + 8192;
constexpr int BM = 256, BK = 64, HALF = 128, HTB = HALF * BK * 2, NXCD = 8, WGM = 8;
__host__ __device__ __forceinline__ int lds_byte(int r, int c) { const int st = (r >> 4) * 2 + (c >> 5), rr = r & 15, cc = c & 31, ob = rr * 64 + cc * 2; return st * 1024 + (ob ^ (((ob >> 9) & 1) << 5)); }
__host__ __device__ __forceinline__ void stage_rc(int b, int& R, int& C) { const int st = b / 1024, sb = b % 1024, swz = sb ^ (((sb >> 9) & 1) << 5); R = (st >> 1) * 16 + swz / 64; C = (st & 1) * 32 + (swz % 64) / 2; }
__host__ __device__ __forceinline__ int perm32(int rho) { const int n = rho >> 4, i = rho & 15; return 8 * (i >> 2) + 4 * n + (i & 3); }

struct GUnit { const char* A; const char* B; unsigned lda, ldb; int nt; int row0, col0, aux, nvalid; const int* gidx; };

__device__ __forceinline__ void tile_of(int L, int nM, int nN, int& pm, int& pn) {
    const int nwg = nM * nN; int wgid = L;
    { const int q = nwg / NXCD, r = nwg % NXCD, xcd = wgid % NXCD, off = wgid / NXCD; wgid = (xcd < r ? xcd * (q + 1) : r * (q + 1) + (xcd - r) * q) + off; }
    const int nig = WGM * nN, gid = wgid / nig, fm = gid * WGM, gsz = (nM - fm) < WGM ? (nM - fm) : WGM;
    pm = fm + ((wgid % nig) % gsz); pn = (wgid % nig) / gsz;
}

template <class Epi, class Sched>
__device__ __forceinline__ void gemm_phase(LAS unsigned char* lds, const Sched& S, const Epi& E) {
    int tid = threadIdx.x; asm volatile("" : "+v"(tid));
    const int wid = __builtin_amdgcn_readfirstlane(tid >> 6), lane = tid & 63, wr = wid >> 2, wc = wid & 3, fr = lane & 15, fq = lane >> 4;
    constexpr int NH = Sched::GATHER ? 2 : 1;
    const size_t kstep = (size_t)(BK * 2);
    const unsigned ldsw = (unsigned)wid * 1024u;
    const int aoff = lds_byte(wr * 64 + fr, fq * 8), boff = lds_byte(wc * 32 + fr, fq * 8);
#define PG8_SA(b, h) (((b) * 2 + (h)) * HTB)
#define PG8_SB(b, h) ((4 + (b) * 2 + (h)) * HTB)
#define PG8_STAGE(bufoff, gbase, voff) do { _Pragma("unroll") for (int _i = 0; _i < 2; ++_i) \
        __builtin_amdgcn_global_load_lds((const unsigned*)((const char*)(gbase) + (voff)[_i]), (LAS unsigned*)(lds + (bufoff) + ldsw + _i * 8192), 16, 0, 0); } while (0)
#define PG8_LD8(p) __builtin_shufflevector(*(const LAS v4i_t*)(p), *(const LAS v4i_t*)((p) + 1024), 0, 1, 2, 3, 4, 5, 6, 7)
#define PG8_LDA(dst, b, h) do { _Pragma("unroll") for (int m = 0; m < 4; ++m) dst[m] = PG8_LD8(lds + PG8_SA(b, h) + aoff + m * 2048); } while (0)
#define PG8_LDB(dst, b, h) do { if (Sched::HALFN && (h) == 1) break; _Pragma("unroll") for (int n = 0; n < 2; ++n) dst[n] = PG8_LD8(lds + PG8_SB(b, h) + boff + n * 2048); } while (0)
#define PG8_LO(x) __builtin_bit_cast(bf16x8, __builtin_shufflevector(x, x, 0, 1, 2, 3))
#define PG8_HI(x) __builtin_bit_cast(bf16x8, __builtin_shufflevector(x, x, 4, 5, 6, 7))
#define PG8_MMA(ai, bj, At, Bt) do { if (Sched::HALFN && (bj) == 1) break; __builtin_amdgcn_s_setprio(1); _Pragma("unroll") for (int m = 0; m < 4; ++m) _Pragma("unroll") for (int n = 0; n < 2; ++n) { \
        if constexpr (Sched::FP8) asm volatile("v_mfma_scale_f32_16x16x128_f8f6f4 %0, %1, %2, %0, %3, %3 op_sel_hi:[0,0,0]" : "+v"(acc[ai][bj][m][n]) : "v"(Bt[n]), "v"(At[m]), "v"(sc1));   \
        else { acc[ai][bj][m][n] = __builtin_amdgcn_mfma_f32_16x16x32_bf16(PG8_LO(Bt[n]), PG8_LO(At[m]), acc[ai][bj][m][n], 0, 0, 0); \
               acc[ai][bj][m][n] = __builtin_amdgcn_mfma_f32_16x16x32_bf16(PG8_HI(Bt[n]), PG8_HI(At[m]), acc[ai][bj][m][n], 0, 0, 0); } } \
        __builtin_amdgcn_s_setprio(0); } while (0)
#define PG8_WAIT_V(n) asm volatile("s_waitcnt vmcnt(" #n ")" ::: "memory")
#define PG8_WAIT_L(n) asm volatile("s_waitcnt lgkmcnt(" #n ")" ::: "memory")
#define PG8_BAR __builtin_amdgcn_s_barrier()
#define PG8_SCHED __builtin_amdgcn_sched_barrier(0)
#define PG8_OFFS(u, oA, oB, IDXL) do { int _tz = threadIdx.x; asm volatile("" : "+v"(_tz)); _Pragma("unroll") for (int _i = 0; _i < 2; ++_i) { int _R, _C; stage_rc(_tz * 16 + _i * 8192, _R, _C); \
        const int _Rb = (_R & ~31) + perm32(_R & 31); \
        _Pragma("unroll") for (int _h = 0; _h < NH; ++_h) { const int _ra = _h * HALF + _R; const int _rowa = Sched::GATHER ? (IDXL ? ((_ra < (u).nvalid) ? (IDXL[_ra] >> 2) : 0) : S.arow(u, _ra)) : _ra; oA[_h][_i] = (unsigned)_rowa * (u).lda + (unsigned)_C * 2u; } \
        oB[_i] = (unsigned)_Rb * (u).ldb + (unsigned)_C * 2u; } } while (0)
    GUnit cur, nxt; int ui = 0;
    if (!S.next(0, cur)) return;
    f32x4 acc[2][2][4][2];
#pragma unroll
    for (int a = 0; a < 2; ++a)
#pragma unroll
        for (int b = 0; b < 2; ++b)
#pragma unroll
            for (int m = 0; m < 4; ++m)
#pragma unroll
                for (int n = 0; n < 2; ++n) acc[a][b][m][n] = (f32x4){0.f, 0.f, 0.f, 0.f};
    v8i_t At[4], B0[2], B1[2];
    const int sc1 = 0x7F7F7F7F;
    unsigned vA[NH][2], vB[2];
    PG8_OFFS(cur, vA, vB, ((const LAS int*)nullptr));
    const char* cA = cur.A; const char* cB = cur.B;
#define HA(p, u) ((p) + (Sched::GATHER ? (size_t)0 : (size_t)HALF * (u).lda))
#define HB(p, u) ((p) + (Sched::HALFN ? (size_t)0 : (size_t)HALF * (u).ldb))
#define VA1 vA[NH - 1]
    PG8_STAGE(PG8_SB(0, 0), cB, vB); PG8_STAGE(PG8_SB(0, 1), HB(cB, cur), vB); PG8_STAGE(PG8_SA(0, 0), cA, vA[0]); PG8_STAGE(PG8_SA(0, 1), HA(cA, cur), VA1);
    if (wr == 1) PG8_BAR;
    PG8_WAIT_V(2); PG8_BAR;
    PG8_STAGE(PG8_SB(1, 0), cB + kstep, vB); PG8_STAGE(PG8_SA(1, 0), cA + kstep, vA[0]); PG8_STAGE(PG8_SB(1, 1), HB(cB, cur) + kstep, vB);
    PG8_WAIT_V(6); PG8_BAR;
    for (;;) {
        bool has_next = false;
        const int nt = cur.nt;
        for (int t = 0; t < nt; t += 2) {
            const bool last = (t == nt - 2);
            if constexpr (Sched::GATHER) { if (t == 0 && wid == 0) { GUnit pf; if (S.next(ui + 1, pf)) {
                __builtin_amdgcn_global_load_lds((const unsigned*)((const char*)pf.gidx + lane * 16), (LAS unsigned*)(lds + GIDX_LDS_OFF + ((ui + 1) & 1) * 1024), 16, 0, 0); } } }
            PG8_LDB(B0, 0, 0); PG8_LDB(B1, 0, 1); PG8_SCHED; PG8_LDA(At, 0, 0); PG8_STAGE(PG8_SA(1, 1), HA(cA, cur) + (size_t)(t + 1) * kstep, VA1);
            PG8_WAIT_V(8); PG8_WAIT_L(0); PG8_BAR; PG8_MMA(0, 0, At, B0); PG8_MMA(0, 1, At, B1); PG8_BAR; PG8_SCHED;
            const char* a2; const char* b2; const char* a2h; const char* b2h;
            if (last) {
                has_next = S.next(ui + 1, nxt);
                if (has_next) { PG8_OFFS(nxt, vA, vB, ((const LAS int*)(lds + GIDX_LDS_OFF + ((ui + 1) & 1) * 1024))); a2 = nxt.A; b2 = nxt.B; a2h = HA(a2, nxt); b2h = HB(b2, nxt); }
                else { a2 = cA; b2 = cB; a2h = HA(a2, cur); b2h = HB(b2, cur); }
            } else { a2 = cA + (size_t)(t + 2) * kstep; b2 = cB + (size_t)(t + 2) * kstep; a2h = HA(a2, cur); b2h = HB(b2, cur); }
            PG8_LDA(At, 0, 1); PG8_STAGE(PG8_SB(0, 0), b2, vB); PG8_STAGE(PG8_SB(0, 1), b2h, vB); PG8_STAGE(PG8_SA(0, 0), a2, vA[0]);
            PG8_WAIT_V(8); PG8_WAIT_L(0); PG8_BAR; PG8_MMA(1, 0, At, B0); PG8_MMA(1, 1, At, B1); PG8_BAR; PG8_SCHED;
            PG8_LDB(B0, 1, 0); PG8_LDB(B1, 1, 1); PG8_SCHED; PG8_LDA(At, 1, 0); PG8_STAGE(PG8_SA(0, 1), a2h, VA1);
            PG8_WAIT_V(8); PG8_WAIT_L(0); PG8_BAR; PG8_MMA(0, 0, At, B0); PG8_MMA(0, 1, At, B1); PG8_BAR; PG8_SCHED;
            PG8_LDA(At, 1, 1); PG8_STAGE(PG8_SB(1, 0), b2 + kstep, vB); PG8_STAGE(PG8_SB(1, 1), b2h + kstep, vB); PG8_STAGE(PG8_SA(1, 0), a2 + kstep, vA[0]);
            PG8_WAIT_V(8); PG8_WAIT_L(0); PG8_BAR; PG8_MMA(1, 0, At, B0); PG8_MMA(1, 1, At, B1); PG8_BAR; PG8_SCHED;
        }
        if (wr == 0) PG8_BAR;
        if constexpr (Sched::FP8) asm volatile("s_nop 15\n\ts_nop 15" ::: "memory");
        if constexpr (Sched::FP8) {
#pragma unroll
            for (int a = 0; a < 2; ++a)
#pragma unroll
                for (int b = 0; b < (Sched::HALFN ? 1 : 2); ++b) asm volatile("" : "+v"(acc[a][b][0][0]), "+v"(acc[a][b][0][1]), "+v"(acc[a][b][1][0]), "+v"(acc[a][b][1][1]), "+v"(acc[a][b][2][0]), "+v"(acc[a][b][2][1]), "+v"(acc[a][b][3][0]), "+v"(acc[a][b][3][1])); }
        { int tz = threadIdx.x; asm volatile("" : "+v"(tz));
          const int wz = __builtin_amdgcn_readfirstlane(tz >> 6), lz = tz & 63; E(acc, cur, wz >> 2, wz & 3, lz & 15, lz >> 4); }
        if (!has_next) break;
#pragma unroll
        for (int a = 0; a < 2; ++a)
#pragma unroll
            for (int b = 0; b < (Sched::HALFN ? 1 : 2); ++b)
#pragma unroll
                for (int m = 0; m < 4; ++m)
#pragma unroll
                    for (int n = 0; n < 2; ++n) acc[a][b][m][n] = (f32x4){0.f, 0.f, 0.f, 0.f};
        cur = nxt; cA = cur.A; cB = cur.B; ++ui;
        if (wr == 1) PG8_BAR;
    }
    PG8_WAIT_V(0);
    PG8_BAR;
#undef PG8_SA
#undef PG8_SB
#undef PG8_STAGE
#undef PG8_LDA
#undef PG8_LDB
#undef PG8_MMA
#undef PG8_LO
#undef PG8_HI
#undef PG8_LD8
#undef PG8_WAIT_V
#undef PG8_WAIT_L
#undef PG8_BAR
#undef PG8_SCHED
#undef PG8_OFFS
#undef HA
#undef HB
#undef VA1
}
}

struct Args { const float* in[N_INPUTS]; float* out; unsigned char* ws; int ph_lo, ph_hi; };

struct Frame {
    LAS unsigned char* lds;
    unsigned char* ws;
    int tid, lane, wave, vcu, G, bx;
};

#define CAS __attribute__((address_space(4)))
__device__ __forceinline__ const float* inp(int i) {
    const CAS char* kp = (const CAS char*)__builtin_amdgcn_kernarg_segment_ptr();
    asm volatile("" : "+s"(kp));
    const unsigned long long v = *(const CAS unsigned long long*)(kp + 8 * i);
    return (const float*)(const GAS float*)v;
}
__device__ __forceinline__ float* outp() {
    const CAS char* kp = (const CAS char*)__builtin_amdgcn_kernarg_segment_ptr();
    asm volatile("" : "+s"(kp));
    const unsigned long long v = *(const CAS unsigned long long*)(kp + 8 * N_INPUTS);
    return (float*)(GAS float*)v;
}
__device__ __forceinline__ unsigned cvt_pk_bf16(float lo, float hi) { unsigned r; asm volatile("v_cvt_pk_bf16_f32 %0, %1, %2" : "=v"(r) : "v"(lo), "v"(hi)); return r; }

template <bool FP8_>
struct SchedDenseT {
    static constexpr bool GATHER = false, FP8 = FP8_, HALFN = false;
    const char* A; const char* B; unsigned lda, ldb; int nt, nM, nN, G, c; int latonly;
    __device__ __forceinline__ int arow(const gm::GUnit&, int r) const { return r; }
    __device__ __forceinline__ bool next(int i, gm::GUnit& u) const {
        const long L = (long)i * G + c; if (L >= (long)nM * nN) return false;
        int pm, pn; gm::tile_of((int)L, nM, nN, pm, pn);
        if (latonly) pm += 1 + (pm >= 32 ? 1 : 0);
        u.A = A + (size_t)pm * 256 * lda; u.B = B + (size_t)pn * 256 * ldb; u.lda = lda; u.ldb = ldb; u.nt = nt; u.row0 = pm * 256; u.col0 = pn * 256; u.aux = 0; u.nvalid = 256; u.gidx = nullptr;
        return true;
    }
};
typedef SchedDenseT<false> SchedDense;
struct SchedMerge {
    static constexpr bool GATHER = false, FP8 = true, HALFN = true;
    const char* OA; size_t ostride; const char* WO; int G, c; int latonly;
    __device__ __forceinline__ int arow(const gm::GUnit&, int r) const { return r; }
    __device__ __forceinline__ bool next(int i, gm::GUnit& u) const {
        const int nM = latonly ? 64 : 66;
        const int j = i / 6, sub = i - 6 * j, nh = sub / 3, br = sub - 3 * nh; const long L = (long)j * G + c; if (L >= nM * 4) return false;
        int pm, pn; gm::tile_of((int)L, nM, 4, pm, pn);
        if (latonly) pm += 1 + (pm >= 32 ? 1 : 0);
        u.A = OA + (size_t)br * ostride + (size_t)pm * 256 * 512; u.B = WO + (size_t)br * (1024 * 512) + (size_t)(pn * 256 + nh * 128) * 512; u.lda = 512; u.ldb = 512; u.nt = 4;
        u.row0 = pm * 256; u.col0 = pn * 256 + nh * 128; u.aux = br; u.nvalid = 256; u.gidx = nullptr; return true;
    }
};
struct SchedUp {
    static constexpr bool GATHER = false, FP8 = true, HALFN = false;
    const char* CQN; const char* WUQ; const char* WUKV; int G, c;
    __device__ __forceinline__ int arow(const gm::GUnit&, int r) const { return r; }
    __device__ __forceinline__ bool next(int i, gm::GUnit& u) const {
        const long L = (long)i * G + c; if (L >= 66 * 7) return false;
        int pm, pn; gm::tile_of((int)L, 66, 7, pm, pn);
        u.lda = 512; u.ldb = 256; u.nt = 2; u.row0 = pm * 256; u.col0 = pn * 256; u.aux = 0; u.nvalid = 256; u.gidx = nullptr;
        if (pn < 3) { u.A = CQN + (size_t)pm * 256 * 512; u.B = WUQ + (size_t)pn * 256 * 256; }
        else { u.A = CQN + (size_t)pm * 256 * 512 + 256; u.B = WUKV + (size_t)(pn - 3) * 256 * 256; }
        return true;
    }
};
template <bool GATHER_, int NTN>
struct SchedMoe {
    static constexpr bool GATHER = GATHER_, FP8 = true, HALFN = false;
    const LAS int* pref;
    const int* cnt;
    const char* A; const char* W; const int* tok; int G, c; unsigned lda; size_t wstride; int nt;
    __device__ __forceinline__ int arow(const gm::GUnit& u, int r) const { return (r < u.nvalid) ? (u.gidx[r] >> 2) : 0; }
    __device__ __forceinline__ bool next(int i, gm::GUnit& u) const {
        const long L = (long)i * G + c; const int tot = pref[32]; if (L >= (long)tot * NTN) return false;
        const int mg = (int)(L / NTN), pn = (int)(L % NTN);
        int e = 0;
#pragma unroll 1
        for (int k = 1; k < 32; ++k) e += (pref[k] <= mg) ? 1 : 0;
        const int mloc = mg - pref[e]; const int n = cnt[e * 16];
        u.nvalid = min(256, n - mloc * 256); u.gidx = tok + (size_t)e * CAP + mloc * 256;
        u.A = GATHER_ ? A : A + (size_t)mg * 256 * lda; u.lda = lda; u.B = W + (size_t)e * wstride + (size_t)pn * 256 * 1024; u.ldb = 1024; u.nt = nt;
        u.row0 = mg * 256; u.col0 = pn; u.aux = e; return true;
    }
};

#define EPI_ARGS f32x4 (&acc)[2][2][4][2], const gm::GUnit& u, int wr, int wc, int fr, int fq
struct EpiBf16 {
    bf16* O; int ldc; float scale;
    __device__ __forceinline__ void operator()(EPI_ARGS) const {
        const int row0 = u.row0 + wr * 64 + fr, col0 = u.col0 + wc * 32 + 8 * fq;
#pragma unroll
        for (int ai = 0; ai < 2; ++ai)
#pragma unroll
            for (int m = 0; m < 4; ++m) { bf16* rowp = O + (size_t)(row0 + ai * 128 + m * 16) * ldc + col0;
#pragma unroll
                for (int bj = 0; bj < 2; ++bj) { const f32x4 v0 = acc[ai][bj][m][0] * scale, v1 = acc[ai][bj][m][1] * scale;
                    u32x4 w; w.x = cvt_pk_bf16(v0[0], v0[1]); w.y = cvt_pk_bf16(v0[2], v0[3]); w.z = cvt_pk_bf16(v1[0], v1[1]); w.w = cvt_pk_bf16(v1[2], v1[3]);
                    *(u32x4*)(rowp + bj * 128) = w; } }
    }
};
struct EpiMerge {
    const bf16* RAW; bf16* Y;
    __device__ __forceinline__ void operator()(EPI_ARGS) const {
        const int br = u.aux; const int row0 = u.row0 + wr * 64 + fr, col = u.col0 + wc * 32 + 8 * fq;
#pragma unroll
        for (int ai = 0; ai < 2; ++ai)
#pragma unroll
            for (int m = 0; m < 4; ++m) { const int row = row0 + ai * 128 + m * 16;
                const u32x4 gw = *(const u32x4*)(RAW + (size_t)row * NINP + CGATE + br * 1024 + col);
                const float g[8] = {bflo(gw.x), bfhi(gw.x), bflo(gw.y), bfhi(gw.y), bflo(gw.z), bfhi(gw.z), bflo(gw.w), bfhi(gw.w)};
                f32x4 y0 = acc[ai][1][m][0], y1 = acc[ai][1][m][1];
                if (br == 0) { y0 = (f32x4){0.f, 0.f, 0.f, 0.f}; y1 = y0; }
#pragma unroll
                for (int j = 0; j < 4; ++j) { y0[j] += sigmoidf_(g[j]) * W8_INV * acc[ai][0][m][0][j]; y1[j] += sigmoidf_(g[4 + j]) * W8_INV * acc[ai][0][m][1][j]; }
                acc[ai][1][m][0] = y0; acc[ai][1][m][1] = y1;
                if (br == 2) { u32x4 w; w.x = cvt_pk_bf16(y0[0], y0[1]); w.y = cvt_pk_bf16(y0[2], y0[3]); w.z = cvt_pk_bf16(y1[0], y1[1]); w.w = cvt_pk_bf16(y1[2], y1[3]);
                    *(u32x4*)(Y + (size_t)row * D + col) = w; } }
    }
};
struct EpiWout {
    float* X; const float* modl;
    __device__ __forceinline__ void operator()(EPI_ARGS) const {
        const int row0 = u.row0 + wr * 64 + fr, col0 = u.col0 + wc * 32 + 8 * fq;
        const int b = u.row0 / TB, rr = u.row0 - b * TB; const int set = (rr < CTX) ? 2 : b;
        const float* g1 = modl + set * 6144 + 2 * 1024;
#pragma unroll
        for (int bj = 0; bj < 2; ++bj) { const int col = col0 + bj * 128;
            const f32x4 ga = *(const f32x4*)(g1 + col), gb = *(const f32x4*)(g1 + col + 4);
#pragma unroll
            for (int ai = 0; ai < 2; ++ai)
#pragma unroll
                for (int m = 0; m < 4; ++m) { float* xp = X + (size_t)(row0 + ai * 128 + m * 16) * D + col;
                    f32x4 x0 = *(const f32x4*)xp, x1 = *(const f32x4*)(xp + 4);
                    x0 += ga * acc[ai][bj][m][0]; x1 += gb * acc[ai][bj][m][1];
                    *(f32x4*)xp = x0; *(f32x4*)(xp + 4) = x1; } }
    }
};
struct EpiMoe1 {
    unsigned char* ACT; const float* bgu;
    __device__ __forceinline__ void operator()(EPI_ARGS) const {
        const int e = u.aux, pn = u.col0; const int row0 = u.row0 + wr * 64 + fr, c0 = pn * 128 + wc * 32 + 8 * fq;
        const float* bg = bgu + (size_t)e * 2048 + c0; const float* bl = bg + 1024;
        const f32x4 bg0 = *(const f32x4*)bg, bg1 = *(const f32x4*)(bg + 4), bl0 = *(const f32x4*)bl, bl1 = *(const f32x4*)(bl + 4);
#pragma unroll
        for (int ai = 0; ai < 2; ++ai)
#pragma unroll
            for (int m = 0; m < 4; ++m) {
                float v[8];
#pragma unroll
                for (int n = 0; n < 2; ++n)
#pragma unroll
                    for (int j = 0; j < 4; ++j) {
                        float glu = acc[ai][0][m][n][j] * W8_INV + (n ? bg1[j] : bg0[j]); float lin = acc[ai][1][m][n][j] * W8_INV + (n ? bl1[j] : bl0[j]);
                        glu = fminf(glu, 7.0f); lin = fminf(fmaxf(lin, -7.0f), 7.0f);
                        v[n * 4 + j] = glu * sigmoidf_(1.702f * glu) * (lin + 1.0f); }
                u32x2 w; w.x = pk4_fp8(v[0], v[1], v[2], v[3]); w.y = pk4_fp8(v[4], v[5], v[6], v[7]);
                *(u32x2*)(ACT + (size_t)(row0 + ai * 128 + m * 16) * D + c0) = w; }
    }
};
struct EpiMoe2 {
    bf16* OUTA; const float* bdn; const float* wl; const int* tok;
    __device__ __forceinline__ void operator()(EPI_ARGS) const {
        const int e = u.aux; const int rl0 = wr * 64 + fr, col0 = u.col0 * 256 + wc * 32 + 8 * fq;
        const float* wlu = wl + (u.gidx - tok);
        const float* bp = bdn + (size_t)e * 1024 + col0;
        const f32x4 b00 = *(const f32x4*)bp, b01 = *(const f32x4*)(bp + 4), b10 = *(const f32x4*)(bp + 128), b11 = *(const f32x4*)(bp + 132);
#pragma unroll
        for (int ai = 0; ai < 2; ++ai)
#pragma unroll
            for (int m = 0; m < 4; ++m) { const int rl = rl0 + ai * 128 + m * 16;
                asm volatile("" ::: "memory");
                if (rl < u.nvalid) { const int aid = u.gidx[rl]; const float w = wlu[rl]; bf16* op = OUTA + (size_t)aid * D + col0;
                    { const f32x4 v0 = (acc[ai][0][m][0] * W8_INV + b00) * w, v1 = (acc[ai][0][m][1] * W8_INV + b01) * w;
                      u32x4 o; o.x = cvt_pk_bf16(v0[0], v0[1]); o.y = cvt_pk_bf16(v0[2], v0[3]); o.z = cvt_pk_bf16(v1[0], v1[1]); o.w = cvt_pk_bf16(v1[2], v1[3]); *(u32x4*)op = o; }
                    { const f32x4 v0 = (acc[ai][1][m][0] * W8_INV + b10) * w, v1 = (acc[ai][1][m][1] * W8_INV + b11) * w;
                      u32x4 o; o.x = cvt_pk_bf16(v0[0], v0[1]); o.y = cvt_pk_bf16(v0[2], v0[3]); o.z = cvt_pk_bf16(v1[0], v1[1]); o.w = cvt_pk_bf16(v1[2], v1[3]); *(u32x4*)(op + 128) = o; } } }
    }
};

namespace at {
__device__ __forceinline__ int crow(int r, int hi) { return (r & 3) + 8 * (r >> 2) + 4 * hi; }
__device__ __forceinline__ void glds16(const void* gsrc, unsigned lds_dst) { unsigned keep;
    asm volatile("s_mov_b32 %0, m0\n\ts_mov_b32 m0, %2\n\ts_nop 0\n\tglobal_load_lds_dwordx4 %1, off\n\ts_mov_b32 m0, %0" : "=&s"(keep) : "v"(gsrc), "s"(lds_dst) : "memory"); }
typedef float f32x2_t __attribute__((ext_vector_type(2))); typedef __bf16 bf16x2_t __attribute__((ext_vector_type(2)));
__device__ __forceinline__ unsigned cvtpk_s(float lo, float hi) { f32x2_t v = {lo, hi}; bf16x2_t b = __builtin_convertvector(v, bf16x2_t); return __builtin_bit_cast(unsigned, b); }
#define AT_SBAR() __builtin_amdgcn_sched_barrier(0)
typedef short v4i16_t __attribute__((ext_vector_type(4)));
struct Tens8 { const unsigned char* Q; int qp; const unsigned char* K; int kp; const unsigned char* Vt; unsigned char* O; };
__device__ __forceinline__ void attn_unit_f8d(LAS unsigned char* lds, const Tens8& tn, int NT, float negM, float lam, const float* subg, float subscale) {
    constexpr int NS = 8, KS = 4096, VS = 4096;
    constexpr int LDS_K = 0, LDS_V = NS * KS, LDS_WS = LDS_V + NS * VS, LDS_OST = LDS_WS + 8 * 512;
    int tid = threadIdx.x; asm volatile("" : "+v"(tid));
    const int lane = tid & 63, r32 = lane & 31, hi = lane >> 5; const int wid = __builtin_amdgcn_readfirstlane(tid >> 6);
    const unsigned lds0 = (unsigned)(size_t)lds;
    const int kc = wid & 3, vc = wid & 3;
    const unsigned kvoff = (wid < 4) ? (unsigned)(lane * tn.kp + kc * 16) : (unsigned)(lane * TB + vc * 16);
    const unsigned kdst = lds0 + LDS_K + kc * 1024, vdst = lds0 + LDS_V + vc * 1024;
    const int NTm1 = NT - 1;
#define FD_DMA_K(j, s) do { const int j_ = min((j), NTm1); glds16(tn.K + (size_t)j_ * 64 * tn.kp + kvoff, (unsigned)__builtin_amdgcn_readfirstlane(kdst + (s) * KS)); } while (0)
#define FD_DMA_V(j, s) do { const int j_ = min((j), NTm1); glds16(tn.Vt + (size_t)j_ * 64 + kvoff, (unsigned)__builtin_amdgcn_readfirstlane(vdst + (s) * VS)); } while (0)
#define FD_PAIR(jk, sk, jv, sv) do { if (wid < 4) FD_DMA_K(jk, sk); else FD_DMA_V(jv, sv); } while (0)
#define FD_WAITBAR() asm volatile("s_waitcnt vmcnt(6) lgkmcnt(0)\n\ts_barrier" ::: "memory")
    const LAS unsigned char* kp0 = lds + LDS_K + (2 * hi) * 1024 + r32 * 16;
    const LAS unsigned char* vp0 = kp0 + (LDS_V - LDS_K);
#define FD_LD8(p) __builtin_shufflevector(*(const LAS v4i_t*)(p), *(const LAS v4i_t*)((p) + 1024), 0, 1, 2, 3, 4, 5, 6, 7)
#define FD_LD6(p) __builtin_shufflevector(*(const LAS v4i_t*)(p), __builtin_shufflevector(*(const LAS v2i_t*)((p) + 1024), *(const LAS v2i_t*)((p) + 1024), 0, 1, -1, -1), 0, 1, 2, 3, 4, 5)
    const unsigned char* Qw = tn.Q + (size_t)(wid * 32 + r32) * tn.qp + 32 * hi;
    const v4i_t qx0 = *(const v4i_t*)(Qw); const v2i_t qx1 = *(const v2i_t*)(Qw + 16);
    v6i_t qm[2];
    { const int z0 = (hi == 0) ? -1 : 0, z1 = (hi == 1) ? -1 : 0;
      qm[0] = (v6i_t){qx0.x & z0, qx0.y & z0, qx0.z & z0, qx0.w & z0, qx1.x & z0, qx1.y & z0}; qm[1] = (v6i_t){qx0.x & z1, qx0.y & z1, qx0.z & z1, qx0.w & z1, qx1.x & z1, qx1.y & z1};
      asm volatile("" : "+v"(qm[0]), "+v"(qm[1])); }
    if (wid < 4) { FD_DMA_K(0, 0); FD_DMA_K(1, 1); }
#pragma unroll
    for (int j = 0; j < NS - 2; ++j) FD_PAIR(j + 2, j + 2, j, j);
    f32x16 negm;
#pragma unroll
    for (int r = 0; r < 16; ++r) negm[r] = negM;
    f32x16 o1[2], o2[2]; o1[0] = f32x16{}; o1[1] = f32x16{}; o2[0] = f32x16{}; o2[1] = f32x16{};
    f32x4 os1 = f32x4{}, os2 = f32x4{};
    v8i_t ones;
    { const int ov_ = ((((lane >> 4) & 1) != 0) == ((lane & 15) >= 8)) ? 0x38383838 : 0;
#pragma unroll
      for (int i = 0; i < 8; ++i) ones[i] = ov_; }
    v6i_t kf[2];
#define FD_KLD(ksl) do { kf[0] = FD_LD6(kp0 + (ksl) * KS); kf[1] = FD_LD6(kp0 + (ksl) * KS + 512); } while (0)
    FD_WAITBAR();
    FD_KLD(0);
    asm volatile("s_waitcnt lgkmcnt(0)\n\ts_barrier" ::: "memory");
    FD_PAIR(NS, 0, NS - 2, NS - 2);
    f32x16 c0, c1, e0, e1;
    v8i_t vf[2], pw1, pw2;
    int sc1 = 0x7F7F7F7F, scK = 0x7E7E7E7E, scQ = 0x77777777; asm volatile("" : "+v"(sc1), "+v"(scK), "+v"(scQ));
#define FD_PAD() asm volatile("s_nop 15\n\ts_nop 15" ::: "memory")
#define FD_KEEP2(a, b) asm volatile("" :: "v"(a), "v"(b))
#define FD_TIE2(a, b) asm volatile("" : "+v"(a), "+v"(b))
#define FD_PADT2(a, b) asm volatile("s_nop 15\n\ts_nop 15" : "+v"(a), "+v"(b))
#define FD_QKF(C, K6, Q6) asm volatile("v_mfma_scale_f32_32x32x64_f8f6f4 %0, %1, %2, %3, %4, %5 op_sel_hi:[0,0,0] cbsz:2 blgp:2" : "=&v"(C) : "v"(K6), "v"(Q6), "v"(negm), "v"(scK), "v"(scQ))
#define FD_ACC(O, PW, V) asm volatile("v_mfma_scale_f32_32x32x64_f8f6f4 %0, %1, %2, %0, %3, %3 op_sel_hi:[0,0,0]" : "+v"(O) : "v"(PW), "v"(V), "v"(sc1))
#define FD_SUM(OS, PW) asm volatile("v_mfma_scale_f32_16x16x128_f8f6f4 %0, %1, %2, %0, %3, %3 op_sel_hi:[0,0,0]" : "+v"(OS) : "v"(PW), "v"(ones), "v"(sc1))
#define FD_CV(PW, C0, C1, w_) do { int a_ = (int)codes4(C0[4 * (w_)], C0[4 * (w_) + 1], C0[4 * (w_) + 2], C0[4 * (w_) + 3]), b_ = (int)codes4(C1[4 * (w_)], C1[4 * (w_) + 1], C1[4 * (w_) + 2], C1[4 * (w_) + 3]); \
        asm volatile("" : "+v"(a_), "+v"(b_));   PW[w_] = a_; PW[4 + (w_)] = b_; } while (0)
    { FD_QKF(c0, kf[0], qm[0]); FD_QKF(c1, kf[1], qm[0]); FD_QKF(e0, kf[0], qm[1]); FD_QKF(e1, kf[1], qm[1]); AT_SBAR(); FD_KLD(1); FD_PADT2(c0, c1);
      FD_CV(pw1, c0, c1, 0); FD_CV(pw1, c0, c1, 1); FD_CV(pw1, c0, c1, 2); FD_CV(pw1, c0, c1, 3); AT_SBAR();
      asm volatile("s_waitcnt vmcnt(5) lgkmcnt(0)\n\ts_barrier" ::: "memory");
      FD_PAIR(NS + 1, 1, NS - 1, NS - 1); }
#define FD_TILE(t_) do { { FD_KEEP2(vf[0], vf[1]); const LAS unsigned char* vp_ = vp0 + (((t_) - 1) & (NS - 1)) * VS; vf[0] = FD_LD8(vp_); vf[1] = FD_LD8(vp_ + 512); } AT_SBAR(); \
        FD_TIE2(e0, e1); FD_QKF(c0, kf[0], qm[0]); FD_QKF(c1, kf[1], qm[0]); AT_SBAR(); FD_CV(pw2, e0, e1, 0); FD_CV(pw2, e0, e1, 1); AT_SBAR();                                             \
        FD_ACC(o1[0], pw1, vf[0]); AT_SBAR(); FD_CV(pw2, e0, e1, 2); AT_SBAR(); FD_ACC(o1[1], pw1, vf[1]); AT_SBAR(); FD_CV(pw2, e0, e1, 3); AT_SBAR(); FD_SUM(os1, pw1); AT_SBAR();         \
        FD_QKF(e0, kf[0], qm[1]); FD_QKF(e1, kf[1], qm[1]); AT_SBAR(); FD_TIE2(c0, c1); FD_CV(pw1, c0, c1, 0); AT_SBAR();                                                                   \
        FD_ACC(o2[0], pw2, vf[0]); AT_SBAR(); FD_KEEP2(kf[0], kf[1]); FD_KLD(((t_) + 1) & (NS - 1)); FD_CV(pw1, c0, c1, 1); FD_CV(pw1, c0, c1, 2); AT_SBAR(); FD_ACC(o2[1], pw2, vf[1]); AT_SBAR(); \
        FD_SUM(os2, pw2); AT_SBAR(); FD_CV(pw1, c0, c1, 3); AT_SBAR(); FD_KEEP2(pw1, pw2); } while (0)
    for (int t = 1; t < NT - 1; t += 2) {
        FD_TILE(t); FD_TILE(t + 1);
        asm volatile("s_waitcnt vmcnt(4) lgkmcnt(0)\n\ts_barrier" ::: "memory");
        FD_PAIR(t + 1 + NS, (t + 1) & (NS - 1), t - 1 + NS, (t - 1) & (NS - 1));
        FD_PAIR(t + 2 + NS, (t + 2) & (NS - 1), t + NS, t & (NS - 1));
    }
    FD_TILE(NT - 1);
#undef FD_TILE
    { const LAS unsigned char* vp_ = vp0 + ((NT - 1) & (NS - 1)) * VS; vf[0] = FD_LD8(vp_); vf[1] = FD_LD8(vp_ + 512); AT_SBAR();
      FD_TIE2(e0, e1); FD_CV(pw2, e0, e1, 0); FD_CV(pw2, e0, e1, 1); FD_CV(pw2, e0, e1, 2); FD_CV(pw2, e0, e1, 3); AT_SBAR();
      FD_ACC(o1[0], pw1, vf[0]); FD_ACC(o1[1], pw1, vf[1]); FD_SUM(os1, pw1); FD_ACC(o2[0], pw2, vf[0]); FD_ACC(o2[1], pw2, vf[1]); FD_SUM(os2, pw2);
      asm volatile("s_nop 15\n\ts_nop 15" : "+v"(o1[0]), "+v"(o1[1]), "+v"(o2[0]), "+v"(o2[1]), "+v"(os1), "+v"(os2)); }
    float val[2][16];
    { LAS float* sm = (LAS float*)(lds + LDS_OST + wid * 2048);
        if ((lane & 7) == 0) { const int sb_ = ((lane & 8) ? 16 : 0) + 4 * (lane >> 4); *(LAS f32x4*)(sm + sb_) = os1; *(LAS f32x4*)(sm + 32 + sb_) = os2; }
        asm volatile("s_waitcnt lgkmcnt(0)" ::: "memory");
#pragma unroll
        for (int k = 0; k < 4; ++k) { const f32x4 t1 = *(const LAS f32x4*)(sm + 8 * k + 4 * hi), t2 = *(const LAS f32x4*)(sm + 32 + 8 * k + 4 * hi);
#pragma unroll
            for (int j = 0; j < 4; ++j) { const int r = 4 * k + j; const float rl1 = __builtin_amdgcn_rcpf(t1[j]); const float rl2 = lam * __builtin_amdgcn_rcpf(t2[j]);
                val[0][r] = o1[0][r] * rl1 - o2[0][r] * rl2; val[1][r] = o1[1][r] * rl1 - o2[1][r] * rl2; } }
        asm volatile("s_waitcnt lgkmcnt(0)" ::: "memory"); }
    { const float g0 = subg[r32] * subscale, g1 = subg[32 + r32] * subscale;
#pragma unroll
        for (int r = 0; r < 16; ++r) { float s = val[0][r] * val[0][r] + val[1][r] * val[1][r];
#pragma unroll
            for (int o = 1; o < 32; o <<= 1) s += shflx(s, o);
            const float rs = rsqrtf(s * (1.0f / 64.0f) + NORM_EPS); val[0][r] *= rs * g0; val[1][r] *= rs * g1; } }
    { LAS unsigned char* stg = lds + LDS_OST + wid * 2048;
#pragma unroll
        for (int r = 0; r < 16; ++r) { const int orow = crow(r, hi); const unsigned w2 = pk4_fp8(val[0][r], val[1][r], 0.f, 0.f);
            stg[orow * 64 + r32] = (unsigned char)w2; stg[orow * 64 + 32 + r32] = (unsigned char)(w2 >> 8); }
        asm volatile("s_waitcnt lgkmcnt(0)" ::: "memory");
        unsigned char* Ow = tn.O + (size_t)(wid * 32) * 512;
        { const int row = lane >> 1, hf = lane & 1; const u32x4 v0 = *(const LAS u32x4*)(stg + row * 64 + hf * 32), v1 = *(const LAS u32x4*)(stg + row * 64 + hf * 32 + 16);
          *(u32x4*)(Ow + (size_t)row * 512 + hf * 32) = v0; *(u32x4*)(Ow + (size_t)row * 512 + hf * 32 + 16) = v1; } }
    asm volatile("s_waitcnt lgkmcnt(0)\n\ts_barrier" ::: "memory");
#undef FD_DMA_K
#undef FD_DMA_V
#undef FD_PAIR
#undef FD_WAITBAR
#undef FD_LD8
#undef FD_LD6
#undef FD_KLD
#undef FD_PAD
#undef FD_KEEP2
#undef FD_TIE2
#undef FD_PADT2
#undef FD_QKF
#undef FD_ACC
#undef FD_SUM
#undef FD_CV
}

template <int KB, bool DIFF, bool F4 = false, int NQB = 1>
__device__ __forceinline__ void attn_unit_x2(LAS unsigned char* lds, const Tens8& tn, int NT, float negM, float lam, const float* subg, float subscale, size_t qbs = 0, size_t obs = 0) {
    constexpr int NS = 4, KS = KB * 64, VS = 4096, KS2 = 2 * KS, VS2 = 2 * VS, NKM = F4 ? KB / 32 : KB / 64;
    constexpr int LDS_K = 0, LDS_V = NS * KS2, LDS_OST = 0;
    static_assert(LDS_V + NS * VS2 <= RING_BYTES && NS * KS2 >= 8 * 2048 && !(F4 && DIFF), "attention LDS");
    int tid = threadIdx.x; asm volatile("" : "+v"(tid));
    const int lane = tid & 63, r32 = lane & 31, hi = lane >> 5; const int wid = __builtin_amdgcn_readfirstlane(tid >> 6);
    const unsigned lds0 = (unsigned)(size_t)lds;
    const int vsub = wid >> 2, vc = wid & 3;
    const unsigned voff = (unsigned)(lane * TB + vsub * 64 + vc * 16), vdst = lds0 + LDS_V + vsub * VS + vc * 1024;
    const int ksub = (KB == 64) ? (wid >> 2) : (KB == 32) ? ((wid >> 1) & 1) : 0, kc = (KB == 64) ? (wid & 3) : (KB == 32) ? (wid & 1) : wid;
    const unsigned koff = (unsigned)((ksub * 64 + lane) * tn.kp + kc * 16), kdst = lds0 + LDS_K + ksub * KS + kc * 1024;
    const int NST = NT >> 1, NTm1 = NT - 1;
#define X2_DMA_K(j, sl) do { if (KB == 32) { if (wid < 4) { const int tt_ = min(2 * (j) + ksub, NTm1) - ksub; glds16(tn.K + (size_t)tt_ * 64 * tn.kp + koff, (unsigned)__builtin_amdgcn_readfirstlane(kdst + (sl) * KS2)); } } \
        else if (KB == 64) { const int tt_ = min(2 * (j) + ksub, NTm1) - ksub; glds16(tn.K + (size_t)tt_ * 64 * tn.kp + koff, (unsigned)__builtin_amdgcn_readfirstlane(kdst + (sl) * KS2)); } \
        else { const int t0_ = min(2 * (j), NTm1), t1_ = min(2 * (j) + 1, NTm1); glds16(tn.K + (size_t)t0_ * 64 * tn.kp + koff, (unsigned)__builtin_amdgcn_readfirstlane(kdst + (sl) * KS2)); \
               glds16(tn.K + (size_t)t1_ * 64 * tn.kp + koff, (unsigned)__builtin_amdgcn_readfirstlane(kdst + (sl) * KS2 + KS)); } } while (0)
#define X2_DMA_V(j, sl) do { const int tt_ = min(2 * (j) + vsub, NTm1) - vsub; glds16(tn.Vt + (size_t)tt_ * 64 + voff, (unsigned)__builtin_amdgcn_readfirstlane(vdst + (sl) * VS2)); } while (0)
#define X2_PAIR(p) do { X2_DMA_K((p), (p) & (NS - 1)); X2_DMA_V((p) - 1, ((p) - 1) & (NS - 1)); } while (0)
#define X2_WAITBAR() do { if (KB == 64 || (KB == 32 && wid < 4)) asm volatile("s_waitcnt vmcnt(2) lgkmcnt(0)\n\ts_barrier" ::: "memory"); else if (KB == 32) asm volatile("s_waitcnt vmcnt(1) lgkmcnt(0)\n\ts_barrier" ::: "memory"); \
        else asm volatile("s_waitcnt vmcnt(3) lgkmcnt(0)\n\ts_barrier" ::: "memory"); } while (0)
    const LAS unsigned char* kp0 = lds + LDS_K + (F4 ? hi : 2 * hi) * 1024 + r32 * 16;
    const LAS unsigned char* vp0 = lds + LDS_V + (2 * hi) * 1024 + r32 * 16;
#define X2_LD4(p) __builtin_shufflevector(*(const LAS v4i_t*)(p), *(const LAS v4i_t*)(p), 0, 1, 2, 3, -1, -1, -1, -1)
#define X2_LD8(p) __builtin_shufflevector(*(const LAS v4i_t*)(p), *(const LAS v4i_t*)((p) + 1024), 0, 1, 2, 3, 4, 5, 6, 7)
    const unsigned char* Qw = tn.Q + (size_t)(wid * 32 + r32) * tn.qp + (F4 ? 16 : 32) * hi;
    constexpr int NQ = DIFF ? 2 : NKM;
    v8i_t qr[NQ];
    v4i_t qr4[F4 ? NQB * NKM : 1];
    if constexpr (F4) {
#pragma unroll
        for (int j = 0; j < NQB; ++j)
#pragma unroll
            for (int m = 0; m < NKM; ++m) { qr4[j * NKM + m] = *(const v4i_t*)(Qw + (size_t)j * qbs + 32 * m); asm volatile("" :: "v"(qr4[j * NKM + m])); } }
    else if constexpr (DIFF) { const v8i_t qx = __builtin_shufflevector(*(const v4i_t*)(Qw), *(const v4i_t*)(Qw + 16), 0, 1, 2, 3, 4, 5, 6, 7);
#pragma unroll
        for (int i = 0; i < 8; ++i) { qr[0][i] = (hi == 0) ? qx[i] : 0; qr[1][i] = (hi == 1) ? qx[i] : 0; } }
    else {
#pragma unroll
        for (int m = 0; m < NKM; ++m) qr[m] = __builtin_shufflevector(*(const v4i_t*)(Qw + 64 * m), *(const v4i_t*)(Qw + 64 * m + 16), 0, 1, 2, 3, 4, 5, 6, 7); }
    if constexpr (!F4) {
#pragma unroll
        for (int m = 0; m < NQ; ++m) asm volatile("" :: "v"(qr[m])); }
    X2_DMA_K(0, 0);
#pragma unroll
    for (int p = 1; p < NS - 1; ++p) X2_PAIR(p);
    f32x16 negm;
#pragma unroll
    for (int r = 0; r < 16; ++r) negm[r] = negM;
    f32x16 o1[2], os1; o1[0] = f32x16{}; o1[1] = f32x16{}; os1 = f32x16{};
    f32x16 o2[2], os2; if (DIFF) { o2[0] = f32x16{}; o2[1] = f32x16{}; os2 = f32x16{}; }
    v8i_t ones;
    if constexpr (DIFF) {
#pragma unroll
        for (int i = 0; i < 8; ++i) ones[i] = 0x38383838; }
    else { const int ov_ = ((((lane >> 4) & 1) != 0) == ((lane & 15) >= 8)) ? 0x38383838 : 0;
#pragma unroll
        for (int i = 0; i < 8; ++i) ones[i] = ov_; }
    f32x4 os4 = f32x4{};
    f32x16 oq[F4 ? NQB : 1][2]; f32x4 osq[F4 ? NQB : 1];
#pragma unroll
    for (int j = 0; j < (F4 ? NQB : 1); ++j) { oq[j][0] = f32x16{}; oq[j][1] = f32x16{}; osq[j] = f32x4{}; }
    constexpr int NKF = DIFF ? 2 : 2 * NKM;
    v8i_t kf[F4 ? 1 : NKF];
    v4i_t kf4[F4 ? NKF : 1];
#define X2_KLD(sl, sub) do { const LAS unsigned char* kb_ = kp0 + (sl) * KS2 + (sub) * KS; if constexpr (DIFF) { kf[0] = X2_LD8(kb_); kf[1] = X2_LD8(kb_ + 512); } \
        else if constexpr (F4) { _Pragma("unroll") for (int h_ = 0; h_ < 2; ++h_) _Pragma("unroll") for (int m_ = 0; m_ < NKM; ++m_) kf4[h_ * NKM + m_] = *(const LAS v4i_t*)(kb_ + m_ * 2048 + h_ * 512); } \
        else { _Pragma("unroll") for (int h_ = 0; h_ < 2; ++h_) _Pragma("unroll") for (int m_ = 0; m_ < NKM; ++m_) kf[h_ * NKM + m_] = X2_LD8(kb_ + m_ * 4096 + h_ * 512); } } while (0)
#define X2_VLD(sl, sub) do { const LAS unsigned char* vb_ = vp0 + (sl) * VS2 + (sub) * VS; vf[0] = X2_LD8(vb_); vf[1] = X2_LD8(vb_ + 512); } while (0)
    X2_WAITBAR();
    X2_KLD(0, 0);
    asm volatile("s_waitcnt lgkmcnt(0)\n\ts_barrier" ::: "memory");
    X2_PAIR(NS - 1);
    f32x16 c0, c1;
    v8i_t vf[2], pw1, pw2;
#define X2_MF(a, b, c, fa) __builtin_amdgcn_mfma_scale_f32_32x32x64_f8f6f4(a, b, c, fa, 0, 0, 0x7F7F7F7F, 0, 0x7F7F7F7F)
#define X2_QK(mp) do { if constexpr (DIFF) { c0 = X2_MF(kf[0], qr[mp], negm, 0); c1 = X2_MF(kf[1], qr[mp], negm, 0); } \
        else { _Pragma("unroll") for (int m_ = 0; m_ < NKM; ++m_) { c0 = X2_MF(kf[m_], qr[m_], (m_ == 0) ? negm : c0, 0); c1 = X2_MF(kf[NKM + m_], qr[m_], (m_ == 0) ? negm : c1, 0); } } } while (0)
#define X2_CVT(PW) do { _Pragma("unroll") for (int w_ = 0; w_ < 4; ++w_) { unsigned a_ = 0u, b_ = 0u; \
        _Pragma("unroll") for (int j_ = 0; j_ < 4; ++j_) { a_ = __builtin_amdgcn_cvt_pk_u8_f32(c0[4 * w_ + j_], j_, a_); b_ = __builtin_amdgcn_cvt_pk_u8_f32(c1[4 * w_ + j_], j_, b_); } \
        PW[w_] = (int)a_; PW[4 + w_] = (int)b_; } } while (0)
#define X2_PV(PW, O, OS) do { O[0] = X2_MF(PW, vf[0], O[0], DIFF ? 0 : 1); O[1] = X2_MF(PW, vf[1], O[1], DIFF ? 0 : 1); OS = X2_MF(PW, ones, OS, DIFF ? 0 : 1); } while (0)
#define X2_SUB(FIRST, psl, psub, nsl, nsub) do { \
        if (!(FIRST)) { X2_VLD(psl, psub); AT_SBAR(); } \
        X2_QK(0); AT_SBAR(); \
        if (!(FIRST)) { X2_PV(pw1, o1, os1); AT_SBAR(); } \
        if constexpr (DIFF) { X2_CVT(pw1); AT_SBAR(); X2_QK(1); AT_SBAR(); if (!(FIRST)) { X2_PV(pw2, o2, os2); AT_SBAR(); } X2_KLD(nsl, nsub); X2_CVT(pw2); AT_SBAR(); } \
        else { X2_KLD(nsl, nsub); X2_CVT(pw1); AT_SBAR(); } } while (0)
    if constexpr (DIFF) {
    X2_SUB(true, 0, 0, 0, 1);
    X2_SUB(false, 0, 0, 1, 0);
    X2_WAITBAR(); X2_PAIR(NS);
    for (int u = 1; u < NST; ++u) {
        const int su = u & (NS - 1), sp = (u - 1) & (NS - 1), sn = (u + 1) & (NS - 1);
        X2_SUB(false, sp, 1, su, 1);
        X2_SUB(false, su, 0, sn, 0);
        X2_WAITBAR(); X2_PAIR(u + NS);
    }
    { X2_VLD((NST - 1) & (NS - 1), 1); X2_PV(pw1, o1, os1); X2_PV(pw2, o2, os2); }
    } else {
    f32x16 d0, d1;
    int sc1 = 0x7F7F7F7F, scK = 0x7E7E7E7E, scQ = 0x76767676; asm volatile("" : "+v"(sc1), "+v"(scK), "+v"(scQ));
#define X2_PAD() asm volatile("s_nop 15\n\ts_nop 15" ::: "memory")
#define X2_KEEPV() asm volatile("" :: "v"(vf[0]), "v"(vf[1]))
#define X2_TIE2(a, b) do { if constexpr (F4) asm volatile("" : "+v"(a), "+v"(b)); } while (0)
#define X2_PADT2(a, b) asm volatile("s_nop 15\n\ts_nop 15" : "+v"(a), "+v"(b))
#define X2_KEEPP() asm volatile("" :: "v"(pw1))
#define X2_KEEPK() do { if constexpr (F4) { _Pragma("unroll") for (int i_ = 0; i_ < NKF; ++i_) asm volatile("" :: "v"(kf4[i_])); } } while (0)
#define X2A_QKF(C, K4, Q4) asm volatile("v_mfma_scale_f32_32x32x64_f8f6f4 %0, %1, %2, %3, %4, %5 op_sel_hi:[0,0,0] cbsz:4 blgp:4" : "=&v"(C) : "v"(K4), "v"(Q4), "v"(negm), "v"(scK), "v"(scQ))
#define X2A_QKA(C, K4, Q4) asm volatile("v_mfma_scale_f32_32x32x64_f8f6f4 %0, %1, %2, %0, %3, %4 op_sel_hi:[0,0,0] cbsz:4 blgp:4" : "+v"(C) : "v"(K4), "v"(Q4), "v"(scK), "v"(scQ))
#define X2A_PV(O, PW, V) asm volatile("v_mfma_scale_f32_32x32x64_f8f6f4 %0, %1, %2, %0, %3, %3 op_sel_hi:[0,0,0] cbsz:1" : "+v"(O) : "v"(PW), "v"(V), "v"(sc1))
#define X2A_SUM(OS, PW) asm volatile("v_mfma_scale_f32_16x16x128_f8f6f4 %0, %1, %2, %0, %3, %3 op_sel_hi:[0,0,0] cbsz:1" : "+v"(OS) : "v"(PW), "v"(ones), "v"(sc1))
#define X2_PVS(PW) do { if constexpr (F4) { X2A_PV(o1[0], PW, vf[0]); X2A_PV(o1[1], PW, vf[1]); X2A_SUM(os4, PW); } \
        else { o1[0] = X2_MF(PW, vf[0], o1[0], 1); o1[1] = X2_MF(PW, vf[1], o1[1], 1); os4 = __builtin_amdgcn_mfma_scale_f32_16x16x128_f8f6f4(PW, ones, os4, 1, 0, 0, 0x7F7F7F7F, 0, 0x7F7F7F7F); } } while (0)
#define X2_MFS(a, b, c) (F4 ? __builtin_amdgcn_mfma_scale_f32_32x32x64_f8f6f4(a, b, c, 4, 4, 0, 0x7E7E7E7E, 0, 0x76767676)   \
                            : __builtin_amdgcn_mfma_scale_f32_32x32x64_f8f6f4(a, b, c, 0, 0, 0, 0x7F7F7F7F, 0, 0x77777777))
#define X2_QKJ(j_) do { X2A_QKF(c0, kf4[0], qr4[(j_) * NKM]); X2A_QKF(c1, kf4[NKM], qr4[(j_) * NKM]); if constexpr (NKM == 2) { X2A_QKA(c0, kf4[1], qr4[(j_) * NKM + 1]); X2A_QKA(c1, kf4[NKM + 1], qr4[(j_) * NKM + 1]); } } while (0)
#define X2_QKB(C0, C1) do { if constexpr (F4) { X2A_QKF(C0, kf4[0], qr4[0]); X2A_QKF(C1, kf4[NKM], qr4[0]); if constexpr (NKM == 2) { X2A_QKA(C0, kf4[1], qr4[1]); X2A_QKA(C1, kf4[NKM + 1], qr4[1]); } } \
        else { _Pragma("unroll") for (int m_ = 0; m_ < NKM; ++m_) { C0 = X2_MFS(kf[m_], qr[m_], (m_ == 0) ? negm : C0); C1 = X2_MFS(kf[NKM + m_], qr[m_], (m_ == 0) ? negm : C1); } } } while (0)
#define X2_CVTB(C0, C1) do { _Pragma("unroll") for (int w_ = 0; w_ < 4; ++w_) { pw1[w_] = (int)codes4(C0[4 * w_], C0[4 * w_ + 1], C0[4 * w_ + 2], C0[4 * w_ + 3]); \
        pw1[4 + w_] = (int)codes4(C1[4 * w_], C1[4 * w_ + 1], C1[4 * w_ + 2], C1[4 * w_ + 3]); } } while (0)
    if constexpr (F4) {
    v8i_t pwq[NQB][2];
#define X2_CV(PW, w_) do { int a_ = (int)codes4(c0[4 * (w_)], c0[4 * (w_) + 1], c0[4 * (w_) + 2], c0[4 * (w_) + 3]), b_ = (int)codes4(c1[4 * (w_)], c1[4 * (w_) + 1], c1[4 * (w_) + 2], c1[4 * (w_) + 3]); \
        asm volatile("" : "+v"(a_), "+v"(b_)); PW[w_] = a_; PW[4 + (w_)] = b_; } while (0)
#define X2_BLK(j_, PPi, PNi, PRE_STMT, MID_STMT) do { __builtin_amdgcn_s_setprio(1); X2_QKJ(j_); AT_SBAR(); PRE_STMT; AT_SBAR(); X2A_PV(oq[j_][0], pwq[j_][PPi], vf[0]); __builtin_amdgcn_s_setprio(0); AT_SBAR(); \
        if constexpr (NKM == 1) asm volatile("s_nop 15\n\ts_nop 5" : "+v"(c0), "+v"(c1) : "v"(pwq[j_][PNi])); else asm volatile("s_nop 15\n\ts_nop 15" : "+v"(c0), "+v"(c1) : "v"(pwq[j_][PNi])); AT_SBAR(); \
        X2_CV(pwq[j_][PNi], 0); X2_CV(pwq[j_][PNi], 1); AT_SBAR(); X2A_PV(oq[j_][1], pwq[j_][PPi], vf[1]); AT_SBAR(); MID_STMT; X2_CV(pwq[j_][PNi], 2); X2_CV(pwq[j_][PNi], 3); AT_SBAR(); X2A_SUM(osq[j_], pwq[j_][PPi]); AT_SBAR(); } while (0)
#define X2_NOP_STMT do { } while (0)
#define X2_SUBT(PPi, PNi, VLD_STMT, KLD_STMT) do { if constexpr (NQB == 1) X2_BLK(0, PPi, PNi, do { X2_KEEPV(); VLD_STMT; } while (0), do { X2_KEEPK(); KLD_STMT; } while (0)); \
        else { X2_BLK(0, PPi, PNi, do { X2_KEEPV(); VLD_STMT; } while (0), X2_NOP_STMT); X2_BLK(NQB - 1, PPi, PNi, X2_NOP_STMT, do { X2_KEEPK(); KLD_STMT; } while (0)); } } while (0)
#pragma unroll
    for (int j = 0; j < NQB; ++j) { X2_QKJ(j); AT_SBAR(); X2_PADT2(c0, c1); X2_CV(pwq[j][0], 0); X2_CV(pwq[j][0], 1); X2_CV(pwq[j][0], 2); X2_CV(pwq[j][0], 3); AT_SBAR(); asm volatile("" : "=v"(pwq[j][1])); }
    X2_KEEPK(); X2_KLD(0, 1); asm volatile("" : "=v"(vf[0]), "=v"(vf[1]));
    X2_SUBT(0, 1, X2_VLD(0, 0), X2_KLD(1, 0));
    X2_WAITBAR(); X2_PAIR(NS);
    for (int u = 1; u < NST; ++u) {
        const int su = u & (NS - 1), sp = (u - 1) & (NS - 1), sn = (u + 1) & (NS - 1);
        X2_SUBT(1, 0, X2_VLD(sp, 1), X2_KLD(su, 1));
        X2_SUBT(0, 1, X2_VLD(su, 0), X2_KLD(sn, 0));
        X2_WAITBAR(); X2_PAIR(u + NS);
    }
    X2_KEEPV(); X2_VLD((NST - 1) & (NS - 1), 1); AT_SBAR();
#pragma unroll
    for (int j = 0; j < NQB; ++j) { X2A_PV(oq[j][0], pwq[j][1], vf[0]); X2A_PV(oq[j][1], pwq[j][1], vf[1]); X2A_SUM(osq[j], pwq[j][1]); }
#pragma unroll
    for (int j = 0; j < NQB; ++j) asm volatile("s_nop 15\n\ts_nop 15" : "+v"(oq[j][0]), "+v"(oq[j][1]), "+v"(osq[j]));
#undef X2_CV
#undef X2_BLK
#undef X2_NOP_STMT
#undef X2_SUBT
    } else {
    X2_QKB(c0, c1); AT_SBAR(); X2_KLD(0, 1);
    X2_QKB(d0, d1); AT_SBAR(); if constexpr (F4) X2_PADT2(c0, c1); X2_CVTB(c0, c1); AT_SBAR(); X2_VLD(0, 0); X2_PVS(pw1); AT_SBAR(); X2_KEEPK(); X2_KLD(1, 0);
    X2_WAITBAR(); X2_PAIR(NS);
    for (int u = 1; u < NST; ++u) {
        const int su = u & (NS - 1), sp = (u - 1) & (NS - 1), sn = (u + 1) & (NS - 1);
        X2_KEEPV(); X2_VLD(sp, 1); AT_SBAR(); __builtin_amdgcn_s_setprio(1); X2_QKB(c0, c1); __builtin_amdgcn_s_setprio(0); AT_SBAR(); X2_KEEPP(); X2_TIE2(d0, d1); X2_CVTB(d0, d1); AT_SBAR(); __builtin_amdgcn_s_setprio(1); X2_PVS(pw1); __builtin_amdgcn_s_setprio(0); AT_SBAR(); X2_KEEPK(); X2_KLD(su, 1);
        X2_KEEPV(); X2_VLD(su, 0); AT_SBAR(); __builtin_amdgcn_s_setprio(1); X2_QKB(d0, d1); __builtin_amdgcn_s_setprio(0); AT_SBAR(); X2_KEEPP(); X2_TIE2(c0, c1); X2_CVTB(c0, c1); AT_SBAR(); __builtin_amdgcn_s_setprio(1); X2_PVS(pw1); __builtin_amdgcn_s_setprio(0); AT_SBAR(); X2_KEEPK(); X2_KLD(sn, 0);
        X2_WAITBAR(); X2_PAIR(u + NS);
    }
    { X2_KEEPV(); if constexpr (F4) X2_PADT2(d0, d1); X2_KEEPP(); X2_CVTB(d0, d1); AT_SBAR(); X2_VLD((NST - 1) & (NS - 1), 1); X2_PVS(pw1); if constexpr (F4) asm volatile("s_nop 15\n\ts_nop 15" : "+v"(o1[0]), "+v"(o1[1]), "+v"(os4)); }
    }
#undef X2_PAD
#undef X2_KEEPV
#undef X2_TIE2
#undef X2_PADT2
#undef X2_KEEPP
#undef X2_KEEPK
#undef X2A_QKF
#undef X2A_QKA
#undef X2A_PV
#undef X2A_SUM
#undef X2_QKB
#undef X2_QKJ
#undef X2_PVS
#undef X2_MFS
#undef X2_CVTB
    }
    asm volatile("s_waitcnt vmcnt(0) lgkmcnt(0)\n\ts_barrier" ::: "memory");
#pragma unroll
    for (int jb = 0; jb < (F4 ? NQB : 1); ++jb) {
    if constexpr (F4) { o1[0] = oq[jb][0]; o1[1] = oq[jb][1]; os4 = osq[jb]; }
    float val[2][16];
    if constexpr (DIFF) {
#pragma unroll
        for (int r = 0; r < 16; ++r) { const float rl1 = __builtin_amdgcn_rcpf(os1[r]); const float rl2 = lam * __builtin_amdgcn_rcpf(os2[r]); val[0][r] = o1[0][r] * rl1 - o2[0][r] * rl2; val[1][r] = o1[1][r] * rl1 - o2[1][r] * rl2; } }
    else { LAS float* sm = (LAS float*)(lds + LDS_OST + wid * 2048);
        if ((lane & 7) == 0) { const int sb_ = ((lane & 8) ? 16 : 0) + 4 * (lane >> 4); *(LAS f32x4*)(sm + sb_) = os4; }
        asm volatile("s_waitcnt lgkmcnt(0)" ::: "memory");
#pragma unroll
        for (int k = 0; k < 4; ++k) { const f32x4 t1 = *(const LAS f32x4*)(sm + 8 * k + 4 * hi);
#pragma unroll
            for (int j = 0; j < 4; ++j) { const int r = 4 * k + j; const float rl1 = __builtin_amdgcn_rcpf(t1[j]); val[0][r] = o1[0][r] * rl1; val[1][r] = o1[1][r] * rl1; } }
        asm volatile("s_waitcnt lgkmcnt(0)" ::: "memory"); }
    if constexpr (DIFF) { const float g0 = subg[r32] * subscale, g1 = subg[32 + r32] * subscale;
#pragma unroll
        for (int r = 0; r < 16; ++r) { float s = val[0][r] * val[0][r] + val[1][r] * val[1][r];
#pragma unroll
            for (int o = 1; o < 32; o <<= 1) s += shflx(s, o);
            const float rs = rsqrtf(s * (1.0f / 64.0f) + NORM_EPS); val[0][r] *= rs * g0; val[1][r] *= rs * g1; } }
    { LAS unsigned char* stg = lds + LDS_OST + wid * 2048;
#pragma unroll
        for (int r = 0; r < 16; ++r) { const int orow = crow(r, hi); const unsigned w2 = pk4_fp8(val[0][r], val[1][r], 0.f, 0.f);
            stg[orow * 64 + r32] = (unsigned char)w2; stg[orow * 64 + 32 + r32] = (unsigned char)(w2 >> 8); }
        asm volatile("s_waitcnt lgkmcnt(0)" ::: "memory");
        unsigned char* Ow = tn.O + (size_t)jb * obs + (size_t)(wid * 32) * 512;
        { const int row = lane >> 1, hf = lane & 1; const u32x4 v0 = *(const LAS u32x4*)(stg + row * 64 + hf * 32), v1 = *(const LAS u32x4*)(stg + row * 64 + hf * 32 + 16);
          *(u32x4*)(Ow + (size_t)row * 512 + hf * 32) = v0; *(u32x4*)(Ow + (size_t)row * 512 + hf * 32 + 16) = v1; } }
    }
    asm volatile("s_waitcnt lgkmcnt(0)\n\ts_barrier" ::: "memory");
#undef X2_DMA_K
#undef X2_DMA_V
#undef X2_PAIR
#undef X2_WAITBAR
#undef X2_LD8
#undef X2_LD4
#undef X2_KLD
#undef X2_VLD
#undef X2_MF
#undef X2_QK
#undef X2_CVT
#undef X2_PV
#undef X2_SUB
}
}

__device__ __forceinline__ void sincos_acc(float af, float& s, float& c) {
    const double a = (double)af; const double n = rint(a * 0.6366197723675814);
    double r = fma(-n, 1.5707963267948966, a); r = fma(-n, 6.123233995736766e-17, r);
    const double r2 = r * r;
    const double sp = r * (1.0 + r2 * (-1.0 / 6 + r2 * (1.0 / 120 + r2 * (-1.0 / 5040 + r2 * (1.0 / 362880 + r2 * (-1.0 / 39916800))))));
    const double cp = 1.0 + r2 * (-0.5 + r2 * (1.0 / 24 + r2 * (-1.0 / 720 + r2 * (1.0 / 40320 + r2 * (-1.0 / 3628800 + r2 * (1.0 / 479001600))))));
    const int q = ((int)n) & 3;
    const double ss = (q == 0) ? sp : (q == 1) ? cp : (q == 2) ? -sp : -cp;
    const double cc = (q == 0) ? cp : (q == 1) ? -sp : (q == 2) ? -cp : sp;
    s = (float)ss; c = (float)cc;
}

__device__ __forceinline__ void cvt_item(const float* W, int ldw, int sg, int kb, bf16* dst, int K, int g, LAS float* scr, int lane) {
    const int k0 = kb * 64;
    f32x4 v[8];
    if (sg >= 0) {
#pragma unroll
        for (int i = 0; i < 8; ++i) { const int kk = i * 8 + (lane >> 3); v[i] = *(const f32x4*)(W + (size_t)(k0 + kk) * ldw + sg * 32 + (lane & 7) * 4); }
    } else {
#pragma unroll
        for (int i = 0; i < 8; ++i) v[i] = (f32x4){0.f, 0.f, 0.f, 0.f};
    }
#pragma unroll
    for (int i = 0; i < 8; ++i) { const int kk = i * 8 + (lane >> 3); LAS float* p = scr + kk * 33 + (lane & 7) * 4; p[0] = v[i][0]; p[1] = v[i][1]; p[2] = v[i][2]; p[3] = v[i][3]; }
    LDS_WAIT();
    const int c = lane & 7;
#pragma unroll
    for (int j = 0; j < 4; ++j) { const int n = (lane >> 3) + 8 * j; const LAS float* s = scr + (8 * c) * 33 + n;
        u32x4 o; o.x = pk2(s[0 * 33], s[1 * 33]); o.y = pk2(s[2 * 33], s[3 * 33]); o.z = pk2(s[4 * 33], s[5 * 33]); o.w = pk2(s[6 * 33], s[7 * 33]);
        *(u32x4*)(dst + (size_t)(g * 32 + n) * K + k0 + 8 * c) = o; }
    LDS_WAIT();
}

__device__ __forceinline__ void cvt_item8(const float* W, int ldw, int sg, int kb, unsigned char* dst, int K, int g, LAS float* scr, int lane) {
    const int k0 = kb * 64;
    f32x4 v[8];
#pragma unroll
    for (int i = 0; i < 8; ++i) { const int kk = i * 8 + (lane >> 3); v[i] = (sg >= 0) ? *(const f32x4*)(W + (size_t)(k0 + kk) * ldw + sg * 32 + (lane & 7) * 4) : (f32x4){0.f, 0.f, 0.f, 0.f}; }
#pragma unroll
    for (int i = 0; i < 8; ++i) { const int kk = i * 8 + (lane >> 3); LAS float* p = scr + kk * 33 + (lane & 7) * 4; p[0] = v[i][0] * W8_SCALE; p[1] = v[i][1] * W8_SCALE; p[2] = v[i][2] * W8_SCALE; p[3] = v[i][3] * W8_SCALE; }
    LDS_WAIT();
    const int c = lane & 3;
#pragma unroll
    for (int j = 0; j < 2; ++j) { const int n = (lane >> 2) + 16 * j; const LAS float* s = scr + (16 * c) * 33 + n;
        u32x4 o; o.x = pk4_fp8(s[0 * 33], s[1 * 33], s[2 * 33], s[3 * 33]); o.y = pk4_fp8(s[4 * 33], s[5 * 33], s[6 * 33], s[7 * 33]);
        o.z = pk4_fp8(s[8 * 33], s[9 * 33], s[10 * 33], s[11 * 33]); o.w = pk4_fp8(s[12 * 33], s[13 * 33], s[14 * 33], s[15 * 33]);
        *(u32x4*)(dst + (size_t)(g * 32 + n) * K + k0 + 16 * c) = o; }
    LDS_WAIT();
}

constexpr int IT_WIN = 184 * 16, IT_UQ = 24 * 4, IT_UKV = 32 * 4, IT_WO = 32 * 8, IT_WOUT = 32 * 16, IT_GU = 64 * 16, IT_DN = 32 * 16;
constexpr int IT_SMALL = IT_WIN + IT_UQ + IT_UKV + 3 * IT_WO + IT_WOUT;
constexpr int IT_LAYER = IT_SMALL + 32 * (IT_GU + IT_DN);
constexpr int IT_CVT = NL * IT_LAYER;
constexpr int IT_MOD = NL * 768, IT_ROPE = 128, IT_MISC = 1;
constexpr int IT_TOTAL = IT_MOD + IT_ROPE + IT_MISC + IT_CVT;

__device__ __forceinline__ void p0_prologue(Frame& F) {
    LAS float* sil = (LAS float*)(F.lds + 73728);
    for (int i = F.tid; i < 3 * 1024; i += NTHREADS) { const int s = i >> 10, k = i & 1023; const float cv = (s < 2) ? inp(I_C)[s * 1024 + k] : inp(I_CCTX)[k]; sil[i] = cv * sigmoidf_(cv); }
    __syncthreads();
    LAS float* scr = (LAS float*)(F.lds + F.wave * 8704);
    const int gw = F.vcu * NWAVES + F.wave, NGW = F.G * NWAVES; const int lane = F.lane;
    float* MOD = (float*)(F.ws + WS_MOD); float* MISC = (float*)(F.ws + WS_MISC);
    for (int it = gw; it < IT_TOTAL; it += NGW) {
        int r = it;
        if (r < IT_MOD) {
            const int l = r / 768, ch = r % 768, kq = lane >> 3, col = ch * 8 + (lane & 7);
            const float* W = inp(I_WMOD) + (size_t)l * 1024 * 6144 + col;
            float a0 = 0.f, a1 = 0.f, a2 = 0.f;
#pragma unroll 16
            for (int i = 0; i < 128; ++i) { const int k = kq * 128 + i; const float w = W[(size_t)k * 6144]; a0 += sil[k] * w; a1 += sil[1024 + k] * w; a2 += sil[2048 + k] * w; }
#pragma unroll
            for (int o = 8; o < 64; o <<= 1) { a0 += shflx(a0, o); a1 += shflx(a1, o); a2 += shflx(a2, o); }
            if (kq == 0) { const float bb = inp(I_BMOD)[l * 6144 + col]; MOD[(l * 3 + 0) * 6144 + col] = a0 + bb; MOD[(l * 3 + 1) * 6144 + col] = a1 + bb; MOD[(l * 3 + 2) * 6144 + col] = a2 + bb; }
            continue; }
        r -= IT_MOD;
        if (r < IT_ROPE) {
            const int pos = r * 64 + lane; const float prow = (float)(pos / 64), pcol = (float)(pos % 64);
            float* c64 = (float*)(F.ws + WS_ROPE64); float* s64 = c64 + 8192 * 32; float* c32 = (float*)(F.ws + WS_ROPE32); float* s32 = c32 + 8192 * 16;
            for (int i = 0; i < 16; ++i) { const float invf = (float)exp2(-(double)i / 16.0 * 13.287712379549449); float s, c;
                sincos_acc(prow * invf, s, c); c64[pos * 32 + i] = c; s64[pos * 32 + i] = s;
                sincos_acc(pcol * invf, s, c); c64[pos * 32 + 16 + i] = c; s64[pos * 32 + 16 + i] = s; }
            for (int i = 0; i < 8; ++i) { const float invf = (float)exp2(-(double)i / 8.0 * 13.287712379549449); float s, c;
                sincos_acc(prow * invf, s, c); c32[pos * 16 + i] = c; s32[pos * 16 + i] = s;
                sincos_acc(pcol * invf, s, c); c32[pos * 16 + 8 + i] = c; s32[pos * 16 + 8 + i] = s; }
            continue; }
        r -= IT_ROPE;
        if (r < IT_MISC) {
            for (int l = 0; l < NL; ++l) {
                const float* cl = inp(I_CLAM) + l * 128;
                const float p1 = (lane < 32) ? cl[lane] * cl[32 + lane] : 0.f, p2 = (lane < 32) ? cl[64 + lane] * cl[96 + lane] : 0.f;
                const float s1 = wave_sum(p1), s2 = wave_sum(p2);
                const float lam_init = 0.8f - 0.6f * expf(-0.3f * (float)l);
                const float gaq = wave_max(fabsf(inp(I_AQN)[l * 64 + lane])), gak = wave_max(fabsf(inp(I_AKN)[l * 64 + lane]));
                const float gbqn = wave_max(fabsf(inp(I_BQN)[l * 96 + lane])), gbqr = wave_max(lane < 32 ? fabsf(inp(I_BQN)[l * 96 + 64 + lane]) : 0.f);
                const float gbkn = wave_max(fabsf(inp(I_BKN)[l * 96 + lane])), gbkr = wave_max(lane < 32 ? fabsf(inp(I_BKN)[l * 96 + 64 + lane]) : 0.f);
                const float gcq = wave_max(lane < 32 ? fabsf(inp(I_CQN)[l * 32 + lane]) : 0.f), gck = wave_max(lane < 32 ? fabsf(inp(I_CKN)[l * 32 + lane]) : 0.f);
                if (lane == 0) { MISC[l * 8 + 0] = expf(s1) - expf(s2) + lam_init; MISC[l * 8 + 1] = 1.0f - lam_init;
                    MISC[l * 8 + 2] = 8.0f * gaq * gak * LOG2E; MISC[l * 8 + 3] = (64.0f * gbqn * gbkn + 32.0f * gbqr * gbkr) * 0.10206207261596577f * LOG2E;
                    MISC[l * 8 + 4] = 5.656854249492381f * gcq * gck * LOG2E; }
            }
            continue; }
        r -= IT_MISC;
        const int l = r / IT_LAYER; r -= l * IT_LAYER;
        if (r < IT_WIN) { const int kb = r / 184, g = r % 184; cvt_item8(inp(I_WIN) + (size_t)l * 1024 * NIN, NIN, g < 181 ? g : -1, kb, (unsigned char*)(F.ws + WS_WIN) + (size_t)l * NINP * 1024, 1024, g, scr, lane); continue; } r -= IT_WIN;
        if (r < IT_UQ) { const int kb = r / 24, g = r % 24; cvt_item8(inp(I_WUQ) + (size_t)l * 256 * 768, 768, g, kb, (unsigned char*)(F.ws + WS_WUQ) + (size_t)l * 768 * 256, 256, g, scr, lane); continue; } r -= IT_UQ;
        if (r < IT_UKV) { const int kb = r / 32, g = r % 32; cvt_item8(inp(I_WUKV) + (size_t)l * 128 * 1024, 1024, (kb < 2) ? g : -1, kb, (unsigned char*)(F.ws + WS_WUKV) + (size_t)l * 1024 * 256, 256, g, scr, lane); continue; } r -= IT_UKV;
        if (r < 3 * IT_WO) { const int br = r / IT_WO, rr = r % IT_WO, kb = rr / 32, g = rr % 32;
            cvt_item8(inp(I_WOA + br) + (size_t)l * 512 * 1024, 1024, g, kb, (unsigned char*)(F.ws + WS_WO) + ((size_t)l * 3 + br) * 1024 * 512, 512, g, scr, lane); continue; } r -= 3 * IT_WO;
        if (r < IT_WOUT) { const int kb = r / 32, g = r % 32; cvt_item(inp(I_WOUT) + (size_t)l * 1024 * 1024, 1024, g, kb, (bf16*)(F.ws + WS_WOUT) + (size_t)l * 1024 * 1024, 1024, g, scr, lane); continue; } r -= IT_WOUT;
        const int e = r / (IT_GU + IT_DN); r -= e * (IT_GU + IT_DN);
        if (r < IT_GU) { const int kb = r / 64, g = r % 64, pn = g >> 3, gi = g & 7; const int sg = (gi < 4) ? (4 * pn + gi) : (32 + 4 * pn + (gi - 4));
            cvt_item8(inp(I_WGU) + ((size_t)l * 32 + e) * 1024 * 2048, 2048, sg, kb, (unsigned char*)(F.ws + WS_WGU) + ((size_t)l * 32 + e) * 2048 * 1024, 1024, g, scr, lane); continue; } r -= IT_GU;
        { const int kb = r / 32, g = r % 32; cvt_item8(inp(I_WDN) + ((size_t)l * 32 + e) * 1024 * 1024, 1024, g, kb, (unsigned char*)(F.ws + WS_WDN) + ((size_t)l * 32 + e) * 1024 * 1024, 1024, g, scr, lane); }
    }
}

template <bool FINAL>
__device__ __forceinline__ void p_norm1(Frame& F, int l) {
    const int gw = F.vcu * NWAVES + F.wave, NGW = F.G * NWAVES, lane = F.lane;
    float* X = (float*)(F.ws + WS_X); unsigned char* H8 = (unsigned char*)(F.ws + WS_H8); const bf16* OUTA = (const bf16*)(F.ws + WS_OUTA); const float* MOD = (const float*)(F.ws + WS_MOD);
    const bool first = (!FINAL && l == 0);
    for (int row0 = gw; row0 < T; row0 += 2 * NGW) {
        f32x4 v[2][4]; u32x2 oa[2][4][4];
#pragma unroll
        for (int q = 0; q < 2; ++q) { const int row = row0 + q * NGW; if (row >= T) continue;
            const int b = row / TB, rr = row - b * TB; const bool isctx = rr < CTX;
            if (FINAL && isctx) continue;
            if (first) { const float* src = isctx ? inp(I_CTX) + (size_t)(b * CTX + rr) * D : inp(I_X) + (size_t)(b * SEQ + rr - CTX) * D;
#pragma unroll
                for (int j = 0; j < 4; ++j) v[q][j] = *(const f32x4*)(src + 4 * lane + 256 * j);
            } else {
#pragma unroll
                for (int j = 0; j < 4; ++j) { const int col = 4 * lane + 256 * j; v[q][j] = *(const f32x4*)(X + (size_t)row * D + col);
#pragma unroll
                    for (int k = 0; k < 4; ++k) oa[q][j][k] = *(const u32x2*)(OUTA + ((size_t)row * 4 + k) * D + col); } } }
#pragma unroll
        for (int q = 0; q < 2; ++q) { const int row = row0 + q * NGW; if (row >= T) continue;
            const int b = row / TB, rr = row - b * TB; const bool isctx = rr < CTX; const int set = isctx ? 2 : b;
            if (FINAL && isctx) continue;
            if (!first) { const float* g2 = MOD + ((size_t)((FINAL ? NL - 1 : l - 1) * 3 + set)) * 6144 + 5 * 1024;
#pragma unroll
                for (int j = 0; j < 4; ++j) { const int col = 4 * lane + 256 * j; f32x4 s = (f32x4){0.f, 0.f, 0.f, 0.f};
#pragma unroll
                    for (int k = 0; k < 4; ++k) { const u32x2 w = oa[q][j][k]; s += (f32x4){bflo(w.x), bfhi(w.x), bflo(w.y), bfhi(w.y)}; }
                    v[q][j] += *(const f32x4*)(g2 + col) * s; } }
            if (FINAL) { float* o = outp() + (size_t)(b * SEQ + rr - CTX) * D;
#pragma unroll
                for (int j = 0; j < 4; ++j) *(f32x4*)(o + 4 * lane + 256 * j) = v[q][j];
                continue; }
            float ss = 0.f;
#pragma unroll
            for (int j = 0; j < 4; ++j) { *(f32x4*)(X + (size_t)row * D + 4 * lane + 256 * j) = v[q][j]; ss += (v[q][j].x * v[q][j].x + v[q][j].y * v[q][j].y) + (v[q][j].z * v[q][j].z + v[q][j].w * v[q][j].w); }
            const float rstd = rsqrtf(wave_sum(ss) * (1.0f / D) + NORM_EPS);
            const float* gain = inp(I_NMIX) + l * D; const float* sh = MOD + ((size_t)(l * 3 + set)) * 6144; const float* sc = sh + 1024;
#pragma unroll
            for (int j = 0; j < 4; ++j) { const int col = 4 * lane + 256 * j; const f32x4 gn = *(const f32x4*)(gain + col), s1 = *(const f32x4*)(sc + col), h1 = *(const f32x4*)(sh + col);
                const f32x4 y = v[q][j] * rstd * gn * (1.0f + s1) + h1;
                *(unsigned*)(H8 + (size_t)row * D + col) = pk4_fp8(y.x, y.y, y.z, y.w); } }
    }
}

struct PieceDesc { int gwl; const float* gain; int rope; int dbase; float scale; bool active; };
template <int RM>
__device__ __forceinline__ void piece_norm(const u32x4 raw, const PieceDesc& pd, int lane, bool lat, int pos, const float* c64, const float* c32, float (&out)[8]) {
    float v[8] = {bflo(raw.x), bfhi(raw.x), bflo(raw.y), bfhi(raw.y), bflo(raw.z), bfhi(raw.z), bflo(raw.w), bfhi(raw.w)};
    float ss = 0.f;
#pragma unroll
    for (int j = 0; j < 8; ++j) ss += v[j] * v[j];
    ss += dppf<DPP_X1>(ss); ss += dppf<DPP_X2>(ss);
    { const float t = dppf<DPP_HM>(ss); ss += (pd.gwl > 4) ? t : 0.f; }
    { const float t = dppf<DPP_RM>(ss); ss += (pd.gwl > 8) ? t : 0.f; }
    { const float t = shflx(ss, 16); ss += (pd.gwl > 16) ? t : 0.f; }
    const float rstd = rsqrtf(ss / (float)(pd.gwl * 8) + NORM_EPS);
    f32x4 g0 = (f32x4){1.f, 1.f, 1.f, 1.f}, g1 = g0;
    if (pd.active) { g0 = *(const f32x4*)pd.gain; g1 = *(const f32x4*)(pd.gain + 4); }
    float y[8];
#pragma unroll
    for (int j = 0; j < 4; ++j) { y[j] = v[j] * rstd * g0[j]; y[4 + j] = v[4 + j] * rstd * g1[j]; }
    const int half = pd.rope >> 1;
    const bool dorope = lat && pd.rope != 0 && pd.active;
    f32x4 cs0 = (f32x4){1.f, 1.f, 1.f, 1.f}, cs1 = cs0, sn0 = (f32x4){0.f, 0.f, 0.f, 0.f}, sn1 = sn0;
    const bool first = pd.dbase < half;
    if (dorope) { const int p = first ? pd.dbase : pd.dbase - half; const float* ct = (RM == 64) ? c64 + (size_t)pos * 32 + p : c32 + (size_t)pos * 16 + p; const float* st = ct + ((RM == 64) ? 8192 * 32 : 8192 * 16);
        cs0 = *(const f32x4*)ct; cs1 = *(const f32x4*)(ct + 4); sn0 = *(const f32x4*)st; sn1 = *(const f32x4*)(st + 4); }
#pragma unroll
    for (int j = 0; j < 8; ++j) { float yp;
        if constexpr (RM == 32) yp = dppf<DPP_X2>(y[j]);
        else { const float pu = dppf<0x104>(y[j])  , pd4 = dppf<0x114>(y[j])  ; yp = (lane & 4) ? pd4 : pu; } const float c = (j < 4) ? cs0[j & 3] : cs1[j & 3], s = (j < 4) ? sn0[j & 3] : sn1[j & 3];
        out[j] = (y[j] * c + (first ? -yp : yp) * s) * pd.scale; }
}
__device__ __forceinline__ u32x4 pack8(const float (&o)[8]) { u32x4 w; w.x = pk2(o[0], o[1]); w.y = pk2(o[2], o[3]); w.z = pk2(o[4], o[5]); w.w = pk2(o[6], o[7]); return w; }

__host__ __device__ __forceinline__ int vt_perm(int kv) { const int top = kv >> 5, w = kv & 31; return 32 * ((w >> 2) & 1) + 16 * top + 4 * (w >> 3) + (w & 3); }
__device__ __forceinline__ void vt8_block(const bf16* src, int sp, unsigned char* dst, LAS unsigned char* scr, int lane) {
    const bf16* rp = src + (size_t)lane * sp; const int p = vt_perm(lane);
    u32x4 r[8];
#pragma unroll
    for (int i = 0; i < 8; ++i) r[i] = *(const u32x4*)(rp + i * 8);
#pragma unroll
    for (int i = 0; i < 8; ++i) {
        const unsigned a = pk4_fp8(bflo(r[i].x), bfhi(r[i].x), bflo(r[i].y), bfhi(r[i].y)), b = pk4_fp8(bflo(r[i].z), bfhi(r[i].z), bflo(r[i].w), bfhi(r[i].w));
#pragma unroll
        for (int j = 0; j < 4; ++j) { scr[(8 * i + j) * 64 + p] = (unsigned char)(a >> (8 * j)); scr[(8 * i + 4 + j) * 64 + p] = (unsigned char)(b >> (8 * j)); } }
    LDS_WAIT();
    unsigned char* dp = dst + (size_t)lane * TB;
#pragma unroll
    for (int i = 0; i < 4; ++i) *(u32x4*)(dp + 16 * i) = *(const LAS u32x4*)(scr + lane * 64 + 16 * i);
    LDS_WAIT();
}
__device__ __forceinline__ void p_post1(Frame& F, int l) {
    const int gw = F.vcu * NWAVES + F.wave, NGW = F.G * NWAVES, lane = F.lane;
    const bf16* RAW = (const bf16*)(F.ws + WS_RAW);
    unsigned char* Q8a = (unsigned char*)(F.ws + WS_Q8A); unsigned char* K8a = (unsigned char*)(F.ws + WS_K8A); unsigned char* K8b = (unsigned char*)(F.ws + WS_K8B);
    unsigned char* CQN8 = (unsigned char*)(F.ws + WS_CQN); unsigned char* Q8c = (unsigned char*)(F.ws + WS_Q8C); unsigned char* K8c = (unsigned char*)(F.ws + WS_K8C);
    const float* c64 = (const float*)(F.ws + WS_ROPE64); const float* c32 = (const float*)(F.ws + WS_ROPE32);
    const float qsA = 4.0f * 0.125f * LOG2E, qsC = 8.0f * 0.17677669529663687f * LOG2E;
    for (int row0 = gw; row0 < T; row0 += 2 * NGW) {
        u32x4 raw2[2][3];
        const int cq_ = lane >> 5, cv_ = lane & 31, crow_ = row0 + cq_ * NGW; const bool cisk = cv_ >= 16;
#pragma unroll
        for (int q = 0; q < 2; ++q) { const int row = row0 + q * NGW; if (row < T) {
#pragma unroll
            for (int p = 0; p < 3; ++p) raw2[q][p] = *(const u32x4*)(RAW + (size_t)row * NINP + 512 * p + 8 * lane); } }
#pragma unroll
        for (int q = 0; q < 2; ++q) { const int row = row0 + q * NGW; if (row >= T) continue;
        const int b = row / TB, rr = row - b * TB; const bool lat = rr >= CTX; const int pos = lat ? rr - CTX : 0;
        u32x4 raw[3];
#pragma unroll
        for (int p = 0; p < 3; ++p) raw[p] = raw2[q][p];
        if (lane < 16) { unsigned zz = 0u; asm volatile("" : "+v"(zz)); *(u32x2*)(CQN8 + (size_t)row * 512 + 384 + lane * 8) = (u32x2){zz, zz}; }
#pragma unroll
        for (int p = 0; p < 3; ++p) {
            const int col = 512 * p + 8 * lane;
            PieceDesc pd; pd.gwl = 4; pd.gain = nullptr; pd.rope = 0; pd.dbase = 0; pd.scale = 1.f; pd.active = false;
            bf16* dst = nullptr; unsigned char* dst8 = nullptr; int kind = 0;
            if (col < CA_K) { pd.gwl = 8; pd.gain = inp(I_AQN) + l * 64 + (col & 63); pd.rope = 64; pd.dbase = col & 63; pd.scale = qsA; pd.active = true; dst8 = Q8a + (size_t)row * 256 + (col >> 1); kind = 4; }
            else if (col < CA_V) { const int c2 = col - CA_K; pd.gwl = 8; pd.gain = inp(I_AKN) + l * 64 + (c2 & 63); pd.rope = 64; pd.dbase = c2 & 63; pd.active = true; dst8 = K8a + (size_t)row * 64 + (c2 >> 1); kind = 4; }
            else if (col < CB_CQ) { }
            else if (col < CB_CKV) { const int c2 = col - CB_CQ; pd.gwl = 32; pd.gain = inp(I_BQAN) + l * 256 + c2; pd.active = true; dst8 = CQN8 + (size_t)row * 512 + c2; kind = 3; }
            else if (col < CB_KR) { const int c2 = col - CB_CKV; pd.gwl = 16; pd.gain = inp(I_BKVAN) + l * 128 + c2; pd.active = true; dst8 = CQN8 + (size_t)row * 512 + 256 + c2; kind = 3; }
            else if (col < CC_Q) { const int c2 = col - CB_KR; pd.gwl = 4; pd.gain = inp(I_BKN) + l * 96 + 64 + c2; pd.rope = 32; pd.dbase = c2; pd.active = true; dst8 = K8b + (size_t)row * 512 + 32 + (c2 >> 1); kind = 5; }
            float o[8]; if (p < 2) piece_norm<64>(raw[p], pd, lane, lat, pos, c64, c32, o); else piece_norm<32>(raw[p], pd, lane, lat, pos, c64, c32, o);
            if (kind == 1) *(u32x4*)dst = pack8(o);
            else if (kind == 4) *(unsigned*)dst8 = pk8_fp4x2(o);
            else if (kind == 5) { const unsigned w4 = pk8_fp4x2(o);
#pragma unroll
                for (int h = 0; h < 8; ++h) *(unsigned*)(dst8 + h * 64) = w4; }
            else if (kind != 0) { u32x2 w8; w8.x = pk4_fp8(o[0], o[1], o[2], o[3]); w8.y = pk4_fp8(o[4], o[5], o[6], o[7]);
                if (kind == 3) *(u32x2*)dst8 = w8;
                else {
#pragma unroll
                    for (int h = 0; h < 8; ++h) *(u32x2*)(dst8 + h * 128) = w8; } }
        }
    }
        if (crow_ < T) {
            const int b = crow_ / TB, rr = crow_ - b * TB; const bool lat = rr >= CTX; const int pos = lat ? rr - CTX : 0;
            u32x4 rc[4];
            { const bf16* src = RAW + (size_t)crow_ * NINP + (cisk ? CC_K : CC_Q) + (cv_ & 15) * 32;
#pragma unroll
              for (int i = 0; i < 4; ++i) rc[i] = *(const u32x4*)(src + 8 * i); }
            float x[32];
#pragma unroll
            for (int i = 0; i < 4; ++i) { x[8 * i] = bflo(rc[i].x); x[8 * i + 1] = bfhi(rc[i].x); x[8 * i + 2] = bflo(rc[i].y); x[8 * i + 3] = bfhi(rc[i].y); x[8 * i + 4] = bflo(rc[i].z); x[8 * i + 5] = bfhi(rc[i].z); x[8 * i + 6] = bflo(rc[i].w); x[8 * i + 7] = bfhi(rc[i].w); }
            float ss = 0.f;
#pragma unroll
            for (int j = 0; j < 32; ++j) ss += x[j] * x[j];
            const float rstd = rsqrtf(ss * (1.0f / 32.0f) + NORM_EPS) * (cisk ? 1.0f : qsC);
            const float* gp = (cisk ? inp(I_CKN) : inp(I_CQN)) + l * 32;
#pragma unroll
            for (int i = 0; i < 8; ++i) { const f32x4 g = *(const f32x4*)(gp + 4 * i);
#pragma unroll
                for (int j = 0; j < 4; ++j) x[4 * i + j] *= rstd * g[j]; }
            if (lat) { const float* ct = c32 + (size_t)pos * 16; const float* st = ct + 8192 * 16;
#pragma unroll
                for (int i = 0; i < 4; ++i) { const f32x4 c = *(const f32x4*)(ct + 4 * i), sn = *(const f32x4*)(st + 4 * i);
#pragma unroll
                    for (int j = 0; j < 4; ++j) { const float x1 = x[4 * i + j], x2 = x[16 + 4 * i + j]; x[4 * i + j] = x1 * c[j] - x2 * sn[j]; x[16 + 4 * i + j] = x2 * c[j] + x1 * sn[j]; } } }
            v16f_t va, vb;
#pragma unroll
            for (int j = 0; j < 16; ++j) { va[j] = x[j]; vb[j] = x[16 + j]; }
            const v6u_t w6 = __builtin_amdgcn_cvt_scalef32_2xpk16_fp6_f32(va, vb, cisk ? 0.5f : 1.0f);
            unsigned char* dst = (cisk ? K8c : Q8c) + (size_t)crow_ * 512 + (cv_ & 15) * 32;
            *(u32x4*)dst = (u32x4){w6[0], w6[1], w6[2], w6[3]}; *(u32x2*)(dst + 16) = (u32x2){w6[4], w6[5]};
        }
    }
    { LAS unsigned char* scr = F.lds + F.wave * 4096; unsigned char* Vt = (unsigned char*)(F.ws + WS_VT8A);
      for (int blk = gw; blk < NB * 2 * 132; blk += NGW) { const int t = blk % 132, bg = blk / 132;
          vt8_block(RAW + ((size_t)(bg >> 1) * TB + (size_t)t * 64) * NINP + CA_V + (bg & 1) * 64, NINP, Vt + (size_t)bg * 64 * TB + (size_t)t * 64, scr, lane); }
      unsigned char* Vc = (unsigned char*)(F.ws + WS_VT8C);
      for (int blk = gw; blk < NB * 8 * 132; blk += NGW) { const int t = blk % 132, bh = blk / 132;
          vt8_block(RAW + ((size_t)(bh >> 3) * TB + (size_t)t * 64) * NINP + CC_V + (bh & 7) * 64, NINP, Vc + (size_t)bh * 64 * TB + (size_t)t * 64, scr, lane); } }
}
__device__ __forceinline__ void p_post2(Frame& F, int l) {
    const int gw = F.vcu * NWAVES + F.wave, NGW = F.G * NWAVES, lane = F.lane;
    const bf16* RAW2 = (const bf16*)(F.ws + WS_RAW2); unsigned char* Q8b = (unsigned char*)(F.ws + WS_Q8B); unsigned char* K8b = (unsigned char*)(F.ws + WS_K8B);
    const float* c64 = (const float*)(F.ws + WS_ROPE64); const float* c32 = (const float*)(F.ws + WS_ROPE32);
    const float qsB = 4.0f * 0.10206207261596577f * LOG2E;
    const int h8 = lane >> 3, i8 = lane & 7, h4 = (lane >> 2) & 7, i4 = lane & 3;
    u32x4 n0 = {}, n1 = {}, n2 = {};
#define P2_LOAD(row_) do { if ((row_) < T) { const bf16* rp_ = RAW2 + (size_t)(row_) * 1792; n0 = *(const u32x4*)(rp_ + h8 * 96 + i8 * 8);        \
        n1 = *(const u32x4*)(rp_ + h4 * 96 + 64 + i4 * 8);        n2 = *(const u32x4*)(rp_ + 768 + h8 * 128 + i8 * 8);        } } while (0)
    P2_LOAD(gw);
    for (int row = gw; row < T; row += NGW) {
        const int b = row / TB, rr = row - b * TB; const bool lat = rr >= CTX; const int pos = lat ? rr - CTX : 0;
        const u32x4 r0 = n0, r1 = n1, r2 = n2;
        P2_LOAD(row + NGW);
        float o[8];
        { PieceDesc pd; pd.gwl = 8; pd.gain = inp(I_BQN) + l * 96 + i8 * 8; pd.rope = 0; pd.dbase = 0; pd.scale = qsB; pd.active = true;
          piece_norm<32>(r0, pd, lane, lat, pos, c64, c32, o); *(unsigned*)(Q8b + (size_t)row * 512 + h8 * 64 + i8 * 4) = pk8_fp4x2(o); }
        { PieceDesc pd; pd.gwl = 4; pd.gain = inp(I_BQN) + l * 96 + 64 + i4 * 8; pd.rope = 32; pd.dbase = i4 * 8; pd.scale = qsB; pd.active = true;
          piece_norm<32>(r1, pd, lane, lat, pos, c64, c32, o); const unsigned w4 = pk8_fp4x2(o);
          if (lane < 32) { *(unsigned*)(Q8b + (size_t)row * 512 + h4 * 64 + 32 + i4 * 4) = w4; unsigned zz = 0u; asm volatile("" : "+v"(zz)); *(unsigned*)(Q8b + (size_t)row * 512 + h4 * 64 + 48 + i4 * 4) = zz; *(unsigned*)(K8b + (size_t)row * 512 + h4 * 64 + 48 + i4 * 4) = zz; } }
        { PieceDesc pd; pd.gwl = 8; pd.gain = inp(I_BKN) + l * 96 + i8 * 8; pd.rope = 0; pd.dbase = 0; pd.scale = 1.f; pd.active = true;
          piece_norm<32>(r2, pd, lane, lat, pos, c64, c32, o); *(unsigned*)(K8b + (size_t)row * 512 + h8 * 64 + i8 * 4) = pk8_fp4x2(o); }
    }
#undef P2_LOAD
    { LAS unsigned char* scr = F.lds + F.wave * 4096; unsigned char* Vt = (unsigned char*)(F.ws + WS_VT8B);
      for (int blk = gw; blk < NB * 8 * 132; blk += NGW) { const int t = blk % 132, bh = blk / 132;
          vt8_block(RAW2 + ((size_t)(bh >> 3) * TB + (size_t)t * 64) * 1792 + 768 + (bh & 7) * 128 + 64, 1792, Vt + (size_t)bh * 64 * TB + (size_t)t * 64, scr, lane); } }
}

__device__ __forceinline__ void p_router(Frame& F, int l) {
    const int lane = F.lane, wave = F.wave, tid = F.tid;
    const float* X = (const float*)(F.ws + WS_X); unsigned char* H8 = (unsigned char*)(F.ws + WS_H8); const float* MOD = (const float*)(F.ws + WS_MOD);
    gu32* cnt = (gu32*)(F.ws + WS_CTL) + CW_CNT + l * 32 * 16;
    int* tok = (int*)(F.ws + WS_TOK); float* wl = (float*)(F.ws + WS_WL);
    constexpr int HP = 17;
    LAS float* hT = (LAS float*)(F.lds);
    LAS float* part = (LAS float*)(F.lds + 73728);
    LAS unsigned* hist = (LAS unsigned*)(F.lds + LDSCTL_OFF + LC_HIST); LAS unsigned* base = (LAS unsigned*)(F.lds + LDSCTL_OFF + LC_BASE);
    LAS unsigned* rec = (LAS unsigned*)(F.lds + LDSCTL_OFF + LC_REC);
    if (tid < 32) hist[tid] = 0u;
    const float* rw = inp(I_RW) + (size_t)l * 1024 * 32; const float* rb = inp(I_RB) + l * 32;
    const float* gain = inp(I_NFFN) + l * D;
    const int e = lane & 31, kh = lane >> 5; const int n16 = lane & 15, kg = lane >> 4;
    const int rows_per_wg = (T + F.G - 1) / F.G;
    const int wg_row0 = F.vcu * rows_per_wg;
#define RT_VALID(lr_, row_) ((lr_) < rows_per_wg && (row_) < T && !(l == NL - 1 && ((row_) % TB) < CTX))
    f32x4 v[2][4];
#define RT_LOAD(bt_) do { _Pragma("unroll") for (int q = 0; q < 2; ++q) { const int lr_ = (bt_) * 16 + 2 * wave + q, row_ = wg_row0 + lr_; if (RT_VALID(lr_, row_)) { \
        _Pragma("unroll") for (int j = 0; j < 4; ++j) v[q][j] = *(const f32x4*)(X + (size_t)row_ * D + 4 * lane + 256 * j); } } } while (0)
    RT_LOAD(0);
    float rwreg[64];
#pragma unroll
    for (int i = 0; i < 32; ++i) { const float* rp_ = rw + (size_t)(128 * wave + 4 * i + kg) * 32 + n16; rwreg[2 * i] = rp_[0]; rwreg[2 * i + 1] = rp_[16]; }
    __syncthreads();
    for (int bt = 0; bt * 16 < rows_per_wg; ++bt) {
#pragma unroll
        for (int q = 0; q < 2; ++q) { const int rl = 2 * wave + q; const int lr = bt * 16 + rl, row = wg_row0 + lr;
            if (RT_VALID(lr, row)) {
                const int b = row / TB, rr = row - b * TB; const int set = (rr < CTX) ? 2 : b;
                const float* sh = MOD + ((size_t)(l * 3 + set)) * 6144 + 3 * 1024; const float* sc = sh + 1024;
                float ss = 0.f;
#pragma unroll
                for (int j = 0; j < 4; ++j) ss += (v[q][j].x * v[q][j].x + v[q][j].y * v[q][j].y) + (v[q][j].z * v[q][j].z + v[q][j].w * v[q][j].w);
                const float rstd = rsqrtf(wave_sum(ss) * (1.0f / D) + NORM_EPS);
#pragma unroll
                for (int j = 0; j < 4; ++j) { const int col = 4 * lane + 256 * j; const f32x4 gn = *(const f32x4*)(gain + col), s1 = *(const f32x4*)(sc + col), h1 = *(const f32x4*)(sh + col);
                    const f32x4 y = v[q][j] * rstd * gn * (1.0f + s1) + h1;
                    *(unsigned*)(H8 + (size_t)row * D + col) = pk4_fp8(y.x, y.y, y.z, y.w);
                    hT[(col + 0) * HP + rl] = y.x; hT[(col + 1) * HP + rl] = y.y; hT[(col + 2) * HP + rl] = y.z; hT[(col + 3) * HP + rl] = y.w; }
            } else { float z = 0.f; asm volatile("" : "+v"(z));
#pragma unroll
                for (int j = 0; j < 4; ++j) { const int col = 4 * lane + 256 * j; hT[(col + 0) * HP + rl] = z; hT[(col + 1) * HP + rl] = z; hT[(col + 2) * HP + rl] = z; hT[(col + 3) * HP + rl] = z; } } }
        __syncthreads();
        RT_LOAD(bt + 1);
        f32x4 acc0 = f32x4{}, acc1 = f32x4{};
        { const LAS float* ap = hT + (128 * wave + kg) * HP + n16;
#pragma unroll
          for (int i = 0; i < 32; ++i) { const float a_ = ap[4 * i * HP]; acc0 = __builtin_amdgcn_mfma_f32_16x16x4f32(a_, rwreg[2 * i], acc0, 0, 0, 0); acc1 = __builtin_amdgcn_mfma_f32_16x16x4f32(a_, rwreg[2 * i + 1], acc1, 0, 0, 0); } }
#pragma unroll
        for (int j = 0; j < 4; ++j) { part[(wave * 16 + 4 * kg + j) * 32 + n16] = acc0[j]; part[(wave * 16 + 4 * kg + j) * 32 + 16 + n16] = acc1[j]; }
        __syncthreads();
        { const int r = tid >> 5; const int lr = bt * 16 + r; const int row = wg_row0 + lr; const bool valid = RT_VALID(lr, row);
            float vv = rb[e];
#pragma unroll
            for (int p = 0; p < 8; ++p) vv += part[(p * 16 + r) * 32 + e];
            unsigned key; { const unsigned ub = __float_as_uint(vv); key = ((ub & 0x80000000u) ? ~ub : (ub | 0x80000000u)); key = (key & ~31u) | (unsigned)(31 - e); }
            float tv[4]; int ti[4];
#pragma unroll
            for (int j = 0; j < 4; ++j) { unsigned k = key;
                k = max(k, dppu<DPP_X1>(k)); k = max(k, dppu<DPP_X2>(k)); k = max(k, dppu<DPP_HM>(k)); k = max(k, dppu<DPP_RM>(k)); k = max(k, (unsigned)shflx((int)k, 16));
                const int bi = 31 - (int)(k & 31u); const unsigned kb = k & ~31u; const unsigned ub = (kb & 0x80000000u) ? (kb & 0x7FFFFFFFu) : ~kb;
                tv[j] = __uint_as_float(ub); ti[j] = bi; if (e == bi) key = 0u; }
            const float e1 = __expf(tv[1] - tv[0]), e2 = __expf(tv[2] - tv[0]), e3 = __expf(tv[3] - tv[0]); const float inv = 1.0f / (1.0f + e1 + e2 + e3);
            if (valid && e < 4) { const int ee = (e == 0) ? ti[0] : (e == 1) ? ti[1] : (e == 2) ? ti[2] : ti[3]; const float ww = ((e == 0) ? 1.0f : (e == 1) ? e1 : (e == 2) ? e2 : e3) * inv;
                const unsigned rank = __hip_atomic_fetch_add(&hist[ee], 1u, __ATOMIC_RELAXED, __HIP_MEMORY_SCOPE_WORKGROUP);
                LAS unsigned* rp = rec + (lr * 4 + e) * 4; rp[0] = (unsigned)ee; rp[1] = rank; rp[2] = __float_as_uint(ww); rp[3] = (unsigned)(row * 4 + e); }
            else if (e < 4 && lr < rows_per_wg) { rec[(lr * 4 + e) * 4] = 0xFFFFFFFFu; }
        }
    }
#undef RT_VALID
#undef RT_LOAD
    __syncthreads();
    if (tid < 32) { const unsigned n = hist[tid]; base[tid] = n ? __hip_atomic_fetch_add(cnt + tid * 16, n, __ATOMIC_RELAXED, __HIP_MEMORY_SCOPE_AGENT) : 0u; }
    __syncthreads();
    const int nrec = min(rows_per_wg, max(0, T - wg_row0)) * 4;
    for (int i = tid; i < nrec; i += NTHREADS) { const LAS unsigned* rp = rec + i * 4; const unsigned ee = rp[0]; if (ee == 0xFFFFFFFFu) continue; const unsigned slot = base[ee] + rp[1];
        tok[(size_t)ee * CAP + slot] = (int)rp[3]; wl[(size_t)ee * CAP + slot] = __uint_as_float(rp[2]); }
    __syncthreads();
}

__device__ __forceinline__ f32x16 small_tile(const bf16* A, int lda, const bf16* Bt, int ldb, int K, f32x16 acc, int lane) {
    const int r = lane & 31, h = lane >> 5;
    const bf16* ap = A + (size_t)r * lda + 8 * h; const bf16* bp = Bt + (size_t)r * ldb + 8 * h;
#pragma unroll 8
    for (int k = 0; k < K; k += 16) { const bf16x8 a = *(const bf16x8*)(ap + k); const bf16x8 b = *(const bf16x8*)(bp + k); acc = __builtin_amdgcn_mfma_f32_32x32x16_bf16(a, b, acc, 0, 0, 0); }
    return acc;
}
__device__ __forceinline__ f32x16 small_tile8(const unsigned char* A, int lda, const unsigned char* Bt, int ldb, int K, f32x16 acc, int lane) {
    const int r = lane & 31, h = lane >> 5;
    const unsigned char* ap = A + (size_t)r * lda + 32 * h; const unsigned char* bp = Bt + (size_t)r * ldb + 32 * h;
#pragma unroll 2
    for (int k = 0; k < K; k += 64) { const v8i_t a = __builtin_shufflevector(*(const v4i_t*)(ap + k), *(const v4i_t*)(ap + k + 16), 0, 1, 2, 3, 4, 5, 6, 7);
        const v8i_t b = __builtin_shufflevector(*(const v4i_t*)(bp + k), *(const v4i_t*)(bp + k + 16), 0, 1, 2, 3, 4, 5, 6, 7);
        acc = __builtin_amdgcn_mfma_scale_f32_32x32x64_f8f6f4(a, b, acc, 0, 0, 0, 0x7F7F7F7F, 0, 0x7F7F7F7F); }
    return acc;
}
__device__ __forceinline__ void ctx_merge_small(Frame& F, int l) {
    const bf16* RAW = (const bf16*)(F.ws + WS_RAW); bf16* Y = (bf16*)(F.ws + WS_Y); const int lane = F.lane, c = lane & 31, hi = lane >> 5;
    const int tt = F.wave >> 2, kq = F.wave & 3;
    LAS float* red = (LAS float*)F.lds;
    for (int base = 0; base < 512; base += 2 * F.G) {
        const int tile = base + tt * F.G + F.vcu; const bool valid = tile < 512;
        const int rb = tile >> 5, cb = tile & 31; const int row0 = (rb >> 3) * TB + (rb & 7) * 32, col0 = cb * 32;
        float y[16];
#pragma unroll
        for (int i = 0; i < 16; ++i) y[i] = 0.f;
#pragma unroll 1
        for (int br = 0; br < 3; ++br) {
            f32x16 acc = f32x16{};
            if (valid) { const unsigned char* O = (const unsigned char*)(F.ws + WS_OA + (size_t)br * (WS_OB - WS_OA)) + (size_t)row0 * 512 + kq * 128;
                const unsigned char* W = (const unsigned char*)(F.ws + WS_WO) + ((size_t)l * 3 + br) * 1024 * 512 + (size_t)col0 * 512 + kq * 128;
                acc = small_tile8(O, 512, W, 512, 128, acc, lane); }
#pragma unroll
            for (int i = 0; i < 16; ++i) red[(F.wave * 16 + i) * 64 + lane] = acc[i];
            __syncthreads();
            if (valid && kq == 0) {
#pragma unroll
                for (int i = 0; i < 16; ++i) { float sum = 0.f;
#pragma unroll
                    for (int q = 0; q < 4; ++q) sum += red[((tt * 4 + q) * 16 + i) * 64 + lane];
                    const int row = row0 + (i & 3) + 8 * (i >> 2) + 4 * hi; const float g = bf2f(RAW[(size_t)row * NINP + CGATE + br * 1024 + col0 + c]); y[i] += sigmoidf_(g) * W8_INV * sum; } }
            __syncthreads();
        }
        if (valid && kq == 0) {
#pragma unroll
            for (int i = 0; i < 16; ++i) { const int row = row0 + (i & 3) + 8 * (i >> 2) + 4 * hi; Y[(size_t)row * D + col0 + c] = (bf16)f2bf(y[i]); } }
    }
}
__device__ __forceinline__ void ctx_wout_small(Frame& F, int l) {
    const bf16* Y = (const bf16*)(F.ws + WS_Y); float* X = (float*)(F.ws + WS_X); const int lane = F.lane, c = lane & 31, hi = lane >> 5;
    const float* g1 = (const float*)(F.ws + WS_MOD) + ((size_t)l * 3 + 2) * 6144 + 2 * 1024;
    const int tt = F.wave >> 2, kq = F.wave & 3;
    LAS float* red = (LAS float*)F.lds;
    for (int base = 0; base < 512; base += 2 * F.G) {
        const int tile = base + tt * F.G + F.vcu; const bool valid = tile < 512;
        const int rb = tile >> 5, cb = tile & 31; const int row0 = (rb >> 3) * TB + (rb & 7) * 32, col0 = cb * 32;
        f32x16 acc = f32x16{};
        if (valid) { const bf16* W = (const bf16*)(F.ws + WS_WOUT) + (size_t)l * 1024 * 1024 + (size_t)col0 * 1024 + kq * 256;
            acc = small_tile(Y + (size_t)row0 * D + kq * 256, D, W, 1024, 256, acc, lane); }
#pragma unroll
        for (int i = 0; i < 16; ++i) red[(F.wave * 16 + i) * 64 + lane] = acc[i];
        __syncthreads();
        if (valid && kq == 0) { const float g = g1[col0 + c];
#pragma unroll
            for (int i = 0; i < 16; ++i) { float sum = 0.f;
#pragma unroll
                for (int q = 0; q < 4; ++q) sum += red[((tt * 4 + q) * 16 + i) * 64 + lane];
                const int row = row0 + (i & 3) + 8 * (i >> 2) + 4 * hi; X[(size_t)row * D + col0 + c] += g * sum; } }
        __syncthreads();
    }
}

constexpr int PH_PER_LAYER = 11, PH_FINAL = 1 + NL * PH_PER_LAYER, N_PHASES = PH_FINAL + 1;

__global__ void __launch_bounds__(NTHREADS, 2) fwd(Args args) {
    extern __shared__ __attribute__((aligned(16))) unsigned char lds_raw[];
    Frame F;
    F.lds = (LAS unsigned char*)lds_raw; F.ws = args.ws;
    F.tid = threadIdx.x; F.lane = F.tid & 63; F.wave = __builtin_amdgcn_readfirstlane(F.tid >> 6);
    F.G = gridDim.x; F.bx = blockIdx.x; { const int bx = blockIdx.x; F.vcu = (F.G % 8 == 0) ? (bx % 8) * (F.G / 8) + bx / 8 : bx; }
    for (int u = F.tid; u < (LDS_BYTES - LDSCTL_OFF) / 4; u += NTHREADS) ((LAS unsigned*)(F.lds + LDSCTL_OFF))[u] = 0u;
    __syncthreads();
    gu32* ctl = (gu32*)(F.ws + WS_CTL);
#if MK_ONE_LAUNCH
    XcdBarrier bar = xcd_barrier_post((unsigned*)ctl + CW_BAR, (volatile LAS unsigned*)(F.lds + LDSCTL_OFF + LC_BAR));
#define GRID_BAR() xcd_barrier(bar)
#else
#define GRID_BAR() do { } while (0)
#endif
    const int lo = args.ph_lo, hi = args.ph_hi; (void)lo; (void)hi;
#ifndef DBG_MASK
#define DBG_MASK 0xFFFFFF
#endif
#if MK_ONE_LAUNCH
#define IN(k) true
#else
#define IN(k) (lo <= (k) && (k) < hi)
#endif
#define EN(j) ((DBG_MASK >> (j)) & 1)
#ifndef DUP_MASK
#define DUP_MASK 0
#endif
#define REP(j) for (int rep_ = 0; rep_ < (((DUP_MASK >> (j)) & 1) ? 2 : 1); ++rep_)
#define SEAM(k) do { if (IN(k) && IN((k) + 1)) GRID_BAR(); } while (0)

#define PH_BEGIN(lv) Frame P; { unsigned long long _w = (unsigned long long)F.ws; unsigned _l = (unsigned)(size_t)F.lds; int _g = F.G, _v = F.vcu, _b = F.bx, _t = threadIdx.x; \
        asm volatile("" : "+s"(_w), "+s"(_l), "+s"(_g), "+s"(_v), "+s"(_b), "+v"(_t)); \
        P.ws = (unsigned char*)(GAS unsigned char*)_w; P.lds = (LAS unsigned char*)_l; P.G = _g; P.vcu = _v; P.bx = _b; P.tid = _t; P.lane = _t & 63; P.wave = __builtin_amdgcn_readfirstlane(_t >> 6); } \
        int pl = (lv); asm volatile("" : "+s"(pl)); \
        const float* MODl = (const float*)(P.ws + WS_MOD) + (size_t)pl * 3 * 6144; const float* MISC = (const float*)(P.ws + WS_MISC) + pl * 8; (void)MODl; (void)MISC;
    if (EN(11) && IN(0)) REP(11) { PH_BEGIN(0); p0_prologue(P); }
    SEAM(0);

    for (int l = 0; l < NL; ++l) {
        const int pb = 1 + l * PH_PER_LAYER;
        if (EN(0) && IN(pb + 0)) { PH_BEGIN(l); p_norm1<false>(P, pl); }
        SEAM(pb + 0);
        if (EN(1) && IN(pb + 1)) REP(1) { PH_BEGIN(l);
            SchedDenseT<true> S{(const char*)(P.ws + WS_H8), (const char*)(P.ws + WS_WIN) + (size_t)pl * NINP * 1024, 1024u, 1024u, 8, 66, 23, P.G, P.bx, 0};
            EpiBf16 E{(bf16*)(P.ws + WS_RAW), NINP, W8_INV};
            gm::gemm_phase(P.lds, S, E);
        }
        SEAM(pb + 1);
        if (EN(2) && IN(pb + 2)) REP(2) { PH_BEGIN(l); p_post1(P, pl); }
        SEAM(pb + 2);
        if (EN(3) && IN(pb + 3)) REP(3) { PH_BEGIN(l);
            SchedUp S{(const char*)(P.ws + WS_CQN), (const char*)(P.ws + WS_WUQ) + (size_t)pl * 768 * 256, (const char*)(P.ws + WS_WUKV) + (size_t)pl * 1024 * 256, P.G, P.bx};
            EpiBf16 E{(bf16*)(P.ws + WS_RAW2), 1792, W8_INV};
            gm::gemm_phase(P.lds, S, E);
        }
        SEAM(pb + 3);
        if (EN(4) && IN(pb + 4)) REP(4) { PH_BEGIN(l); p_post2(P, pl); }
        SEAM(pb + 4);
#define ATT_UNITS(...) do { for (int pass = 0; pass < ((pl == NL - 1) ? 1 : 2); ++pass) { const int nu = pass ? 16 : 512; for (int uu = P.vcu; uu < nu; uu += P.G) { \
                const int bh = pass ? uu : (uu & 255) >> 4; const int qb = pass ? 0 : 1 + 16 * (uu >> 8) + (uu & 15); \
                const int b = bh >> 3, h = bh & 7; const size_t qrow = (size_t)b * TB + (size_t)qb * 256, krow = (size_t)b * TB; const int NT = qb ? 132 : 4; __VA_ARGS__ } } } while (0)
#define ATT_UNITS2(NQB_, ...) do { const int nu = (NQB_ == 2) ? 256 : 16; for (int uu = P.vcu; uu < nu; uu += P.G) { const int bh = (NQB_ == 2) ? uu >> 4 : uu; const int qb = (NQB_ == 2) ? 1 + (uu & 15) : 0; \
                const int b = bh >> 3, h = bh & 7; const size_t qrow = (size_t)b * TB + (size_t)qb * 256, krow = (size_t)b * TB; const int NT = qb ? 132 : 4; __VA_ARGS__ } } while (0)
        if (EN(5) && EN(14) && IN(pb + 5)) REP(14) { PH_BEGIN(l); const float MA = MISC[2];
#define ATT_A(NQB_) ATT_UNITS2(NQB_, { at::Tens8 tn{(const unsigned char*)(P.ws + WS_Q8A) + qrow * 256 + h * 32, 256, (const unsigned char*)(P.ws + WS_K8A) + krow * 64 + (h >> 2) * 32, 64, \
                              (const unsigned char*)(P.ws + WS_VT8A) + (size_t)(b * 2 + (h >> 2)) * 64 * TB, (unsigned char*)(P.ws + WS_OA) + qrow * 512 + h * 64}; \
                  at::attn_unit_x2<32, false, true, NQB_>(P.lds, tn, NT, (4.0f * (8.0f - MA) + 60.5f) * (1.0f / 256.0f), 0.f, nullptr, 0.f, (size_t)16 * 256 * 256, (size_t)16 * 256 * 512); })
            ATT_A(2); if (pl != NL - 1) ATT_A(1);
#undef ATT_A
        }
        if (EN(5) && EN(15) && IN(pb + 5)) REP(15) { PH_BEGIN(l); const float MB = MISC[3];
#define ATT_B(NQB_) ATT_UNITS2(NQB_, { at::Tens8 tn{(const unsigned char*)(P.ws + WS_Q8B) + qrow * 512 + h * 64, 512, (const unsigned char*)(P.ws + WS_K8B) + krow * 512 + h * 64, 512, \
                              (const unsigned char*)(P.ws + WS_VT8B) + (size_t)(b * 8 + h) * 64 * TB, (unsigned char*)(P.ws + WS_OB) + qrow * 512 + h * 64}; \
                  at::attn_unit_x2<64, false, true, NQB_>(P.lds, tn, NT, (4.0f * (8.0f - MB) + 60.5f) * (1.0f / 256.0f), 0.f, nullptr, 0.f, (size_t)16 * 256 * 512, (size_t)16 * 256 * 512); })
            ATT_B(2); if (pl != NL - 1) ATT_B(1);
#undef ATT_B
        }
        if (EN(5) && EN(16) && IN(pb + 5)) REP(16) { PH_BEGIN(l); const float lam = MISC[0], subscale = MISC[1], MC = MISC[4]; const float* subg = inp(I_CSUB) + pl * 64;
            ATT_UNITS({ at::Tens8 tn{(const unsigned char*)(P.ws + WS_Q8C) + qrow * 512 + h * 64, 512, (const unsigned char*)(P.ws + WS_K8C) + krow * 512 + h * 64, 512,
                              (const unsigned char*)(P.ws + WS_VT8C) + (size_t)(b * 8 + h) * 64 * TB, (unsigned char*)(P.ws + WS_OC) + qrow * 512 + h * 64};
                  at::attn_unit_f8d(P.lds, tn, NT, (104.0f - 8.0f * MC - 0.34f + 0.5f) * (1.0f / 256.0f), lam, subg, subscale); }); }
#undef ATT_UNITS
#undef ATT_UNITS2
        SEAM(pb + 5);
        if (EN(6) && IN(pb + 6)) REP(6) { PH_BEGIN(l);
            SchedMerge S{(const char*)(P.ws + WS_OA), (size_t)(WS_OB - WS_OA), (const char*)(P.ws + WS_WO) + (size_t)pl * 3 * 1024 * 512, P.G, P.bx, 1};
            if (pl != NL - 1) ctx_merge_small(P, pl);
            EpiMerge E{(const bf16*)(P.ws + WS_RAW), (bf16*)(P.ws + WS_Y)};
            gm::gemm_phase(P.lds, S, E);
        }
        SEAM(pb + 6);
        if (EN(7) && IN(pb + 7)) { PH_BEGIN(l);
            SchedDense S{(const char*)(P.ws + WS_Y), (const char*)(P.ws + WS_WOUT) + (size_t)pl * 1024 * 1024 * 2, 2048u, 2048u, 16, 64, 4, P.G, P.bx, 1};
            if (pl != NL - 1) ctx_wout_small(P, pl);
            EpiWout E{(float*)(P.ws + WS_X), MODl};
            gm::gemm_phase(P.lds, S, E);
        }
        SEAM(pb + 7);
        if (EN(8) && IN(pb + 8)) { PH_BEGIN(l); p_router(P, pl); }
        SEAM(pb + 8);
#define MOE_PREF() LAS int* pref = (LAS int*)(P.lds + LDSCTL_OFF + LC_PREF); const int* cnt = (const int*)(P.ws + WS_CTL) + CW_CNT + pl * 32 * 16; \
            __syncthreads(); \
            if (P.tid == 0) { int s_ = 0; for (int e = 0; e < 32; ++e) { pref[e] = s_; const int n = __hip_atomic_load(cnt + e * 16, __ATOMIC_RELAXED, __HIP_MEMORY_SCOPE_AGENT); s_ += (n + 255) >> 8; } pref[32] = s_; } \
            __syncthreads();
        if (EN(9) && EN(12) && IN(pb + 9)) REP(12) { PH_BEGIN(l); MOE_PREF();
            SchedMoe<true, 8> S{pref, cnt, (const char*)(P.ws + WS_H8), (const char*)(P.ws + WS_WGU) + (size_t)pl * 32 * 2048 * 1024, (const int*)(P.ws + WS_TOK), P.G, P.bx, 1024u, (size_t)2048 * 1024, 8};
            EpiMoe1 E{(unsigned char*)(P.ws + WS_ACT), inp(I_BGU) + (size_t)pl * 32 * 2048};
            gm::gemm_phase(P.lds, S, E);
        }
        SEAM(pb + 9);
        if (EN(9) && EN(10) && IN(pb + 10)) REP(10) { PH_BEGIN(l); MOE_PREF();
            SchedMoe<false, 4> S{pref, cnt, (const char*)(P.ws + WS_ACT), (const char*)(P.ws + WS_WDN) + (size_t)pl * 32 * 1024 * 1024, (const int*)(P.ws + WS_TOK), P.G, P.bx, 1024u, (size_t)1024 * 1024, 8};
            EpiMoe2 E{(bf16*)(P.ws + WS_OUTA), inp(I_BDN) + (size_t)pl * 32 * 1024, (const float*)(P.ws + WS_WL), (const int*)(P.ws + WS_TOK)};
            gm::gemm_phase(P.lds, S, E);
        }
#undef MOE_PREF
        SEAM(pb + 10);
    }
    if (EN(13) && IN(PH_FINAL)) { PH_BEGIN(NL); p_norm1<true>(P, pl); }
#undef PH_BEGIN
#undef IN
#undef SEAM
}

extern "C" void kernel_launch(void* const* d_in, const int* in_sizes, int n_in, void* d_out, int out_size, void* d_ws, size_t ws_size, hipStream_t stream) {
    static int grid = 0;
    if (grid == 0) {
        if (n_in != N_INPUTS || ws_size < WS_END) { fprintf(stderr, "kernel_launch: expected %d inputs and >= %zu bytes of workspace, got %d and %zu\n", (int)N_INPUTS, (size_t)WS_END, n_in, ws_size); grid = -1; return; }
        int dev = 0, cus = 0;
        if (hipGetDevice(&dev) != hipSuccess || hipDeviceGetAttribute(&cus, hipDeviceAttributeMultiprocessorCount, dev) != hipSuccess) { grid = -1; return; }
        if (hipFuncSetAttribute((const void*)fwd, hipFuncAttributeMaxDynamicSharedMemorySize, LDS_BYTES) != hipSuccess) { fprintf(stderr, "kernel_launch: hipFuncSetAttribute failed\n"); grid = -1; return; }
        int per_cu = 0;
        if (hipOccupancyMaxActiveBlocksPerMultiprocessor(&per_cu, (const void*)fwd, NTHREADS, LDS_BYTES) != hipSuccess || per_cu < 1) { fprintf(stderr, "kernel_launch: occupancy query reports %d\n", per_cu); }
        (void)hipGetLastError();
        grid = cus;
    }
    if (grid < 0) return;
    (void)hipMemsetAsync((char*)d_ws + WS_CTL, 0, CTL_ZERO_BYTES, stream);
    Args a{};
    for (int i = 0; i < N_INPUTS; ++i) a.in[i] = (const float*)d_in[i];
    a.out = (float*)d_out; a.ws = (unsigned char*)d_ws;
#if MK_ONE_LAUNCH
    a.ph_lo = 0; a.ph_hi = N_PHASES;
    hipLaunchKernelGGL(fwd, dim3(grid), dim3(NTHREADS), LDS_BYTES, stream, a);
#else
    for (int p = 0; p < N_PHASES; ++p) { a.ph_lo = p; a.ph_hi = p + 1; hipLaunchKernelGGL(fwd, dim3(grid), dim3(NTHREADS), LDS_BYTES, stream, a); }
#endif
}
```

```cpp
#include <hip/hip_runtime.h>
#include <cstdio>
#include <cstdint>

#ifndef MK_ONE_LAUNCH
#define MK_ONE_LAUNCH 1
#endif

#define GAS __attribute__((address_space(1)))
#define LAS __attribute__((address_space(3)))
typedef unsigned short bf16;
typedef short bf16x8 __attribute__((ext_vector_type(8)));
typedef short s16x4 __attribute__((ext_vector_type(4)));
typedef float f32x4 __attribute__((ext_vector_type(4)));
typedef float f32x2 __attribute__((ext_vector_type(2)));
typedef float f32x16 __attribute__((ext_vector_type(16)));
typedef unsigned u32x4 __attribute__((ext_vector_type(4)));
typedef unsigned u32x2 __attribute__((ext_vector_type(2)));
typedef float v16f_t __attribute__((ext_vector_type(16)));
typedef unsigned v6u_t __attribute__((ext_vector_type(6)));
typedef GAS unsigned gu32;
typedef int v4i_t __attribute__((ext_vector_type(4)));
typedef int v2i_t __attribute__((ext_vector_type(2)));
typedef int v6i_t __attribute__((ext_vector_type(6)));
typedef int v8i_t __attribute__((ext_vector_type(8)));

constexpr int D = 1024, NB = 2, SEQ = 8192, CTX = 256, TB = SEQ + CTX, T = NB * TB, NL = 4;
constexpr int NIN = 5792, NINP = 5888;
constexpr int CA_Q = 0, CA_K = 512, CA_V = 640, CB_CQ = 768, CB_CKV = 1024, CB_KR = 1152, CC_Q = 1184, CC_K = 1696, CC_V = 2208, CGATE = 2720;
constexpr int NE = 32, CAP = T, MAXSLOT = 75776;
constexpr float NORM_EPS = 1e-6f;
constexpr float LOG2E = 1.4426950408889634f;

enum { I_X = 0, I_C, I_CTX, I_CCTX, I_WMOD, I_BMOD, I_NMIX, I_NFFN, I_WIN, I_AQN, I_AKN, I_BQAN, I_BKVAN, I_WUQ, I_WUKV, I_BQN, I_BKN, I_CQN, I_CKN, I_CLAM, I_CSUB,
       I_WOA, I_WOB, I_WOC, I_WOUT, I_RW, I_RB, I_WGU, I_BGU, I_WDN, I_BDN, N_INPUTS };

constexpr size_t MiB = 1u << 20;
constexpr size_t WS_CTL = 0, CTL_ZERO_BYTES = 1 * MiB;
constexpr size_t WS_MOD = 1 * MiB;
constexpr size_t WS_MISC = 1 * MiB + 512 * 1024;
constexpr size_t WS_ROPE64 = 2 * MiB;
constexpr size_t WS_ROPE32 = 4 * MiB;
constexpr size_t WS_TOK = 6 * MiB;
constexpr size_t WS_WL = 9 * MiB;
constexpr size_t WS_WIN = 16 * MiB;
constexpr size_t WS_WUQ = 62 * MiB;
constexpr size_t WS_WUKV = 64 * MiB;
constexpr size_t WS_WO = 66 * MiB;
constexpr size_t WS_WOUT = 78 * MiB;
constexpr size_t WS_WGU = 96 * MiB;
constexpr size_t WS_WDN = 608 * MiB;
constexpr size_t WS_X = 864 * MiB;
constexpr size_t WS_H = 930 * MiB;
constexpr size_t WS_RAW = 964 * MiB;
constexpr size_t WS_CQN = 1154 * MiB;
constexpr size_t WS_RAW2 = 1168 * MiB;
constexpr size_t WS_QA = 1226 * MiB, WS_KA = 1243 * MiB, WS_QB = 1248 * MiB, WS_KB = 1273 * MiB, WS_QC = 1298 * MiB, WS_KC = 1315 * MiB;
constexpr size_t WS_OA = 1332 * MiB, WS_OB = 1349 * MiB, WS_OC = 1366 * MiB;
constexpr size_t WS_Y = 1383 * MiB;
constexpr size_t WS_YP = 1416 * MiB;
constexpr size_t WS_ACT = 1482 * MiB;
constexpr size_t WS_OUTA = 1630 * MiB;
constexpr size_t WS_H8 = 1762 * MiB;
constexpr size_t WS_Q8A = 1780 * MiB;
constexpr size_t WS_K8A = 1789 * MiB;
constexpr size_t WS_VT8A = 1792 * MiB;
constexpr size_t WS_Q8B = 1795 * MiB;
constexpr size_t WS_K8B = 1812 * MiB;
constexpr size_t WS_VT8B = 1829 * MiB;
constexpr size_t WS_Q8C = 1840 * MiB;
constexpr size_t WS_K8C = 1849 * MiB;
constexpr size_t WS_VT8C = 1858 * MiB;
constexpr size_t WS_END = 1868 * MiB;
constexpr int CW_TMO = 0, CW_BAR = 4096, CW_CNT = 16384;

constexpr int RING_BYTES = 131072;
constexpr int LDSCTL_OFF = RING_BYTES;
constexpr int LDS_BYTES = 147456;
constexpr int LC_BAR = 0, LC_PREF = 256, LC_HIST = 512, LC_BASE = 640, LC_REC = 1024, LC_UNIT = 5376, LC_UNIT2 = 6400, LC_CNTRAW = 7424;
constexpr int MOE_MAXU = 64;

constexpr int NWAVES = 8, NTHREADS = 512;

#define LDS_WAIT() asm volatile("s_waitcnt lgkmcnt(0)" ::: "memory")
#define VM_WAIT() asm volatile("s_waitcnt vmcnt(0)" ::: "memory")
#define RLX_AGENT __ATOMIC_RELAXED, __HIP_MEMORY_SCOPE_AGENT

__device__ __forceinline__ unsigned f2bf(float f) { unsigned u = __builtin_bit_cast(unsigned, f); return (u + 0x7fffu + ((u >> 16) & 1u)) >> 16; }
__device__ __forceinline__ unsigned pk2(float lo, float hi) { return f2bf(lo) | (f2bf(hi) << 16); }
__device__ __forceinline__ float bf2f(unsigned short b) { return __builtin_bit_cast(float, ((unsigned)b) << 16); }
__device__ __forceinline__ float bflo(unsigned w) { return __builtin_bit_cast(float, w << 16); }
__device__ __forceinline__ float bfhi(unsigned w) { return __builtin_bit_cast(float, w & 0xffff0000u); }
__device__ __forceinline__ unsigned pk4_fp8(float a, float b, float c, float d) { int w = 0; w = __builtin_amdgcn_cvt_pk_fp8_f32(a, b, w, false); w = __builtin_amdgcn_cvt_pk_fp8_f32(c, d, w, true); return (unsigned)w; }
typedef short v2s_t __attribute__((ext_vector_type(2)));
__device__ __forceinline__ unsigned pk8_fp4x2(const float (&o)[8]) { unsigned w = 0u;
    w = __builtin_amdgcn_cvt_scalef32_pk_fp4_f32(w, o[0], o[1], 0.5f, 0); w = __builtin_amdgcn_cvt_scalef32_pk_fp4_f32(w, o[2], o[3], 0.5f, 1);
    w = __builtin_amdgcn_cvt_scalef32_pk_fp4_f32(w, o[4], o[5], 0.5f, 2); w = __builtin_amdgcn_cvt_scalef32_pk_fp4_f32(w, o[6], o[7], 0.5f, 3); return w; }
__device__ __forceinline__ unsigned pk4_fp8s(float a, float b, float c, float d, float scale) {
    v2s_t w = {0, 0}; w = __builtin_amdgcn_cvt_scalef32_pk_fp8_f32(w, a, b, scale, false); w = __builtin_amdgcn_cvt_scalef32_pk_fp8_f32(w, c, d, scale, true); return __builtin_bit_cast(unsigned, w); }
__device__ __forceinline__ unsigned pk4_bf8(float a, float b, float c, float d) { int w = 0; w = __builtin_amdgcn_cvt_pk_bf8_f32(a, b, w, false); w = __builtin_amdgcn_cvt_pk_bf8_f32(c, d, w, true); return (unsigned)w; }
typedef unsigned short us2_t __attribute__((ext_vector_type(2)));
__device__ __forceinline__ unsigned codes4(float a, float b, float c, float d) {
    const unsigned lo = __builtin_bit_cast(unsigned, __builtin_amdgcn_cvt_pknorm_u16(a, b)), hi = __builtin_bit_cast(unsigned, __builtin_amdgcn_cvt_pknorm_u16(c, d));
    return __builtin_amdgcn_perm(hi, lo, 0x07050301u); }
constexpr float W8_SCALE = 32.0f, W8_INV = 1.0f / 32.0f;
__device__ __forceinline__ int lane_l() { int t = threadIdx.x; asm volatile("" : "+v"(t)); return t & 63; }
__device__ __forceinline__ float shflx(float v, int m) { return __builtin_bit_cast(float, __builtin_amdgcn_ds_bpermute((lane_l() ^ m) << 2, __builtin_bit_cast(int, v))); }
__device__ __forceinline__ int shflx(int v, int m) { return __builtin_amdgcn_ds_bpermute((lane_l() ^ m) << 2, v); }
__device__ __forceinline__ float shfl_from(float v, int src) { return __builtin_bit_cast(float, __builtin_amdgcn_ds_bpermute(src << 2, __builtin_bit_cast(int, v))); }
template <int CTRL> __device__ __forceinline__ float dppf(float v) { return __builtin_bit_cast(float, __builtin_amdgcn_update_dpp(0, __builtin_bit_cast(int, v), CTRL, 0xF, 0xF, true)); }
template <int CTRL> __device__ __forceinline__ unsigned dppu(unsigned v) { return (unsigned)__builtin_amdgcn_update_dpp(0, (int)v, CTRL, 0xF, 0xF, true); }
constexpr int DPP_X1 = 0xB1, DPP_X2 = 0x4E, DPP_HM = 0x141, DPP_RM = 0x140;
__device__ __forceinline__ float row_sum16(float v) { v += dppf<DPP_X1>(v); v += dppf<DPP_X2>(v); v += dppf<DPP_HM>(v); v += dppf<DPP_RM>(v); return v; }
__device__ __forceinline__ float wave_sum(float v) {
    v = row_sum16(v);
    const float s0 = __builtin_bit_cast(float, __builtin_amdgcn_readlane(__builtin_bit_cast(int, v), 0)), s1 = __builtin_bit_cast(float, __builtin_amdgcn_readlane(__builtin_bit_cast(int, v), 16));
    const float s2 = __builtin_bit_cast(float, __builtin_amdgcn_readlane(__builtin_bit_cast(int, v), 32)), s3 = __builtin_bit_cast(float, __builtin_amdgcn_readlane(__builtin_bit_cast(int, v), 48));
    return (s0 + s1) + (s2 + s3);
}
__device__ __forceinline__ float wave_max(float v) {
#pragma unroll
    for (int o = 1; o < 64; o <<= 1) v = fmaxf(v, shflx(v, o));
    return v;
}
__device__ __forceinline__ float sigmoidf_(float x) { return __builtin_amdgcn_rcpf(1.0f + __builtin_amdgcn_exp2f(-x * LOG2E)); }

#define XB_TMO      128
#define XB_XCNT(j)  (256  + 64 * (j))
#define XB_XSUB(j)  (1280 + 64 * (j))
#define XB_XGEN(j)  (2304 + 64 * (j))
#define XB_TOP      3328
#define XB_TOPGEN   3392
#define XCD_BAR_WORDS 3456
#define XB_SPIN_CAP (1u << 22)
__device__ __forceinline__ unsigned xb_ld(unsigned* p)              { return __hip_atomic_load(p, __ATOMIC_RELAXED, __HIP_MEMORY_SCOPE_AGENT); }
__device__ __forceinline__ unsigned xb_add(unsigned* p, unsigned v) { return __hip_atomic_fetch_add(p, v, __ATOMIC_RELAXED, __HIP_MEMORY_SCOPE_AGENT); }
__device__ __forceinline__ unsigned xb_xcc_id() { return (unsigned)__builtin_amdgcn_s_getreg((3 << 11) | 20) & 0xFu; }
#define XB_SPIN(cond, bar) do { unsigned _sp = 0; while (cond) { __builtin_amdgcn_s_sleep(1); \
    if ((++_sp & 255u) == 0u) { if (xb_ld(&(bar)[XB_TMO])) break; if (_sp > XB_SPIN_CAP) { atomicAdd(&(bar)[XB_TMO], 1u); break; } } } } while (0)
struct XcdBarrier { unsigned* bar; unsigned x; volatile LAS unsigned* st; };
__device__ __forceinline__ XcdBarrier xcd_barrier_post(unsigned* bar, volatile LAS unsigned* st) {
    XcdBarrier b; b.bar = bar; b.x = xb_xcc_id(); b.st = st;
    if (threadIdx.x == 0) (void)xb_add(&bar[XB_XCNT(b.x)], 1u);
    return b;
}
__device__ __forceinline__ void xcd_barrier_complete(unsigned* bar, unsigned x, unsigned& nloc, unsigned& nx) {
    const unsigned G = gridDim.x * gridDim.y * gridDim.z;
    unsigned sum, cnt, mine, sp = 0u;
    for (;;) {
        sum = 0u; cnt = 0u; mine = 0u;
#pragma unroll
        for (unsigned j = 0; j < 16; ++j) { const unsigned c = xb_ld(&bar[XB_XCNT(j)]); sum += c; cnt += (c > 0u) ? 1u : 0u; mine = (j == x) ? c : mine; }
        if (sum == G) break;
        __builtin_amdgcn_s_sleep(1);
        if ((++sp & 255u) == 0u) { if (xb_ld(&bar[XB_TMO])) break; if (sp > XB_SPIN_CAP) { atomicAdd(&bar[XB_TMO], 1u); break; } }
    }
    nloc = mine > 0u ? mine : 1u; nx = cnt > 0u ? cnt : 1u;
}
__device__ __forceinline__ void xcd_barrier(const XcdBarrier& b) {
    asm volatile("s_waitcnt vmcnt(0)" ::: "memory");
    __syncthreads();
    if (threadIdx.x == 0) {
        unsigned* bar; { unsigned long long bp_ = (unsigned long long)b.bar; asm volatile("" : "+s"(bp_)); bar = (unsigned*)(GAS unsigned*)bp_; }
        unsigned bx_ = b.x; asm volatile("" : "+s"(bx_));
        __builtin_amdgcn_s_waitcnt(0);
        unsigned nloc = b.st[0], nx = b.st[1];
        if (nloc == 0u) { xcd_barrier_complete(bar, bx_, nloc, nx); b.st[0] = nloc; b.st[1] = nx; }
        const unsigned old = xb_add(&bar[XB_XSUB(bx_)], 1u);
        const unsigned gen = old / nloc;
        if (old + 1u == (gen + 1u) * nloc) {
            __builtin_amdgcn_fence(__ATOMIC_RELEASE, "agent");
            asm volatile("s_waitcnt vmcnt(0)" ::: "memory");
            const unsigned og = xb_add(&bar[XB_TOP], 1u);
            const unsigned tg = og / nx;
            if (og + 1u == (tg + 1u) * nx) xb_add(&bar[XB_TOPGEN], 1u);
            else XB_SPIN(xb_ld(&bar[XB_TOPGEN]) == tg, bar);
            __builtin_amdgcn_fence(__ATOMIC_ACQUIRE, "agent");
            xb_add(&bar[XB_XGEN(bx_)], 1u);
            asm volatile("s_waitcnt vmcnt(0)" ::: "memory");
        } else {
            XB_SPIN(xb_ld(&bar[XB_XGEN(bx_)]) == gen, bar);
            __builtin_amdgcn_fence(__ATOMIC_ACQUIRE, "agent");
            asm volatile("s_waitcnt vmcnt(0)" ::: "memory");
        }
    }
    __syncthreads();
}

namespace gm {
constexpr int PF_LDS_OFF = 131072 + 8192 + 2048, PF_SLOT = 3072;
constexpr int GIDX_LDS_OFF = 131072 + 8192;
constexpr int BM = 256, BK = 64, HALF = 128, HTB = HALF * BK * 2, NXCD = 8, WGM = 8;
__host__ __device__ __forceinline__ int lds_byte(int r, int c) { const int st = (r >> 4) * 2 + (c >> 5), rr = r & 15, cc = c & 31, ob = rr * 64 + cc * 2; return st * 1024 + (ob ^ (((ob >> 9) & 1) << 5)); }
__host__ __device__ __forceinline__ void stage_rc(int b, int& R, int& C) { const int st = b / 1024, sb = b % 1024, swz = sb ^ (((sb >> 9) & 1) << 5); R = (st >> 1) * 16 + swz / 64; C = (st & 1) * 32 + (swz % 64) / 2; }
__host__ __device__ __forceinline__ int perm32(int rho) { const int n = rho >> 4, i = rho & 15; return 8 * (i >> 2) + 4 * n + (i & 3); }

struct GUnit { const char* A; const char* B; unsigned lda, ldb; int nt; int row0, col0, aux, nvalid; const int* gidx; };

__device__ __forceinline__ void tile_of(int L, int nM, int nN, int& pm, int& pn) {
    const int nwg = nM * nN; int wgid = L;
    { const int q = nwg / NXCD, r = nwg % NXCD, xcd = wgid % NXCD, off = wgid / NXCD; wgid = (xcd < r ? xcd * (q + 1) : r * (q + 1) + (xcd - r) * q) + off; }
    const int nig = WGM * nN, gid = wgid / nig, fm = gid * WGM, gsz = (nM - fm) < WGM ? (nM - fm) : WGM;
    pm = fm + ((wgid % nig) % gsz); pn = (wgid % nig) / gsz;
}

template <class Epi, class Sched>
__device__ __forceinline__ void gemm_phase(LAS unsigned char* lds, const Sched& S, const Epi& E) {
    int tid = threadIdx.x; asm volatile("" : "+v"(tid));
    const int wid = __builtin_amdgcn_readfirstlane(tid >> 6), lane = tid & 63, wr = wid >> 2, wc = wid & 3, fr = lane & 15, fq = lane >> 4;
    constexpr int NH = Sched::GATHER ? 2 : 1;
    const size_t kstep = (size_t)(BK * 2);
    const unsigned ldsw = (unsigned)wid * 1024u;
    const int aoff = lds_byte(wr * 64 + fr, fq * 8), boff = lds_byte(wc * 32 + fr, fq * 8);
#define PG8_SA(b, h) (((b) * 2 + (h)) * HTB)
#define PG8_SB(b, h) ((4 + (b) * 2 + (h)) * HTB)
#define PG8_STAGE(bufoff, gbase, voff) do { _Pragma("unroll") for (int _i = 0; _i < 2; ++_i) \
        __builtin_amdgcn_global_load_lds((const unsigned*)((const char*)(gbase) + (voff)[_i]), (LAS unsigned*)(lds + (bufoff) + ldsw + _i * 8192), 16, 0, 0); } while (0)
#define PG8_LD8(p) __builtin_shufflevector(*(const LAS v4i_t*)(p), *(const LAS v4i_t*)((p) + 1024), 0, 1, 2, 3, 4, 5, 6, 7)
#define PG8_LDA(dst, b, h) do { _Pragma("unroll") for (int m = 0; m < 4; ++m) dst[m] = PG8_LD8(lds + PG8_SA(b, h) + aoff + m * 2048); } while (0)
#define PG8_LDB(dst, b, h) do { if (Sched::HALFN && (h) == 1) break; _Pragma("unroll") for (int n = 0; n < 2; ++n) dst[n] = PG8_LD8(lds + PG8_SB(b, h) + boff + n * 2048); } while (0)
#define PG8_LO(x) __builtin_bit_cast(bf16x8, __builtin_shufflevector(x, x, 0, 1, 2, 3))
#define PG8_HI(x) __builtin_bit_cast(bf16x8, __builtin_shufflevector(x, x, 4, 5, 6, 7))
#define PG8_MMA(ai, bj, At, Bt) do { if (Sched::HALFN && (bj) == 1) break; __builtin_amdgcn_s_setprio(1); _Pragma("unroll") for (int m = 0; m < 4; ++m) _Pragma("unroll") for (int n = 0; n < 2; ++n) { \
        if constexpr (Sched::FP8) asm volatile("v_mfma_scale_f32_16x16x128_f8f6f4 %0, %1, %2, %0, %3, %3 op_sel_hi:[0,0,0]" : "+v"(acc[ai][bj][m][n]) : "v"(Bt[n]), "v"(At[m]), "v"(sc1));   \
        else { acc[ai][bj][m][n] = __builtin_amdgcn_mfma_f32_16x16x32_bf16(PG8_LO(Bt[n]), PG8_LO(At[m]), acc[ai][bj][m][n], 0, 0, 0); \
               acc[ai][bj][m][n] = __builtin_amdgcn_mfma_f32_16x16x32_bf16(PG8_HI(Bt[n]), PG8_HI(At[m]), acc[ai][bj][m][n], 0, 0, 0); } } \
        __builtin_amdgcn_s_setprio(0); } while (0)
#define PG8_WAIT_V(n) asm volatile("s_waitcnt vmcnt(" #n ")" ::: "memory")
#define PG8_WAIT_L(n) asm volatile("s_waitcnt lgkmcnt(" #n ")" ::: "memory")
#define PG8_BAR __builtin_amdgcn_s_barrier()
#define PG8_SCHED __builtin_amdgcn_sched_barrier(0)
#define PG8_OFFS(u, oA, oB, IDXL) do { int _tz = threadIdx.x; asm volatile("" : "+v"(_tz)); _Pragma("unroll") for (int _i = 0; _i < 2; ++_i) { int _R, _C; stage_rc(_tz * 16 + _i * 8192, _R, _C); \
        const int _Rb = (Sched::BADJ ? (_R >> 5) * 64 : (_R & ~31)) + perm32(_R & 31); \
        _Pragma("unroll") for (int _h = 0; _h < NH; ++_h) { const int _ra = _h * HALF + _R; const int _rowa = Sched::GATHER ? (IDXL ? ((_ra < (u).nvalid) ? (IDXL[_ra] >> 2) : 0) : S.arow(u, _ra)) : _ra; oA[_h][_i] = (unsigned)_rowa * (u).lda + (unsigned)_C * 2u; } \
        oB[_i] = (unsigned)_Rb * (u).ldb + (unsigned)_C * 2u; } } while (0)
    GUnit cur, nxt; int ui = 0;
    if (!S.next(0, cur)) return;
    f32x4 acc[2][2][4][2];
#pragma unroll
    for (int a = 0; a < 2; ++a)
#pragma unroll
        for (int b = 0; b < 2; ++b)
#pragma unroll
            for (int m = 0; m < 4; ++m)
#pragma unroll
                for (int n = 0; n < 2; ++n) acc[a][b][m][n] = (f32x4){0.f, 0.f, 0.f, 0.f};
    v8i_t At[4], B0[2], B1[2];
    const int sc1 = 0x7F7F7F7F;
    unsigned vA[NH][2], vB[2];
    PG8_OFFS(cur, vA, vB, ((const LAS int*)nullptr));
    const char* cA = cur.A; const char* cB = cur.B;
#define HA(p, u) ((p) + (Sched::GATHER ? (size_t)0 : (size_t)HALF * (u).lda))
#define HB(p, u) ((p) + (Sched::HALFN ? (size_t)0 : (size_t)(Sched::BADJ ? 32 : HALF) * (u).ldb))
#define VA1 vA[NH - 1]
    if constexpr (Epi::PF) { if (wid == 1) E.prefetch(cur, lds + PF_LDS_OFF, lane); }
    PG8_STAGE(PG8_SB(0, 0), cB, vB); PG8_STAGE(PG8_SB(0, 1), HB(cB, cur), vB); PG8_STAGE(PG8_SA(0, 0), cA, vA[0]); PG8_STAGE(PG8_SA(0, 1), HA(cA, cur), VA1);
    if (wr == 1) PG8_BAR;
    PG8_WAIT_V(2); PG8_BAR;
    PG8_STAGE(PG8_SB(1, 0), cB + kstep, vB); PG8_STAGE(PG8_SA(1, 0), cA + kstep, vA[0]); PG8_STAGE(PG8_SB(1, 1), HB(cB, cur) + kstep, vB);
    PG8_WAIT_V(6); PG8_BAR;
    for (;;) {
        bool has_next = false;
        const int nt = cur.nt;
        for (int t = 0; t < nt; t += 2) {
            const bool last = (t == nt - 2);
            if constexpr (Epi::PF) { if (t == 2 && wid == 1) { GUnit pf; if (S.next(ui + 1, pf)) E.prefetch(pf, lds + PF_LDS_OFF + ((ui + 1) & 1) * PF_SLOT, lane); } }
            if constexpr (Sched::GATHER) { if (t == 0 && wid == 0) { GUnit pf; if (S.next(ui + 1, pf)) {
                __builtin_amdgcn_global_load_lds((const unsigned*)((const char*)pf.gidx + lane * 16), (LAS unsigned*)(lds + GIDX_LDS_OFF + ((ui + 1) & 1) * 1024), 16, 0, 0); } } }
            PG8_LDB(B0, 0, 0); PG8_LDB(B1, 0, 1); PG8_SCHED; PG8_LDA(At, 0, 0); PG8_STAGE(PG8_SA(1, 1), HA(cA, cur) + (size_t)(t + 1) * kstep, VA1);
            PG8_WAIT_V(8); PG8_WAIT_L(0); PG8_BAR; PG8_MMA(0, 0, At, B0); PG8_MMA(0, 1, At, B1); PG8_BAR; PG8_SCHED;
            const char* a2; const char* b2; const char* a2h; const char* b2h;
            if (last) {
                has_next = S.next(ui + 1, nxt);
                if (has_next) { PG8_OFFS(nxt, vA, vB, ((const LAS int*)(lds + GIDX_LDS_OFF + ((ui + 1) & 1) * 1024))); a2 = nxt.A; b2 = nxt.B; a2h = HA(a2, nxt); b2h = HB(b2, nxt); }
                else { a2 = cA; b2 = cB; a2h = HA(a2, cur); b2h = HB(b2, cur); }
            } else { a2 = cA + (size_t)(t + 2) * kstep; b2 = cB + (size_t)(t + 2) * kstep; a2h = HA(a2, cur); b2h = HB(b2, cur); }
            PG8_LDA(At, 0, 1); PG8_STAGE(PG8_SB(0, 0), b2, vB); PG8_STAGE(PG8_SB(0, 1), b2h, vB); PG8_STAGE(PG8_SA(0, 0), a2, vA[0]);
            PG8_WAIT_V(8); PG8_WAIT_L(0); PG8_BAR; PG8_MMA(1, 0, At, B0); PG8_MMA(1, 1, At, B1); PG8_BAR; PG8_SCHED;
            PG8_LDB(B0, 1, 0); PG8_LDB(B1, 1, 1); PG8_SCHED; PG8_LDA(At, 1, 0); PG8_STAGE(PG8_SA(0, 1), a2h, VA1);
            PG8_WAIT_V(8); PG8_WAIT_L(0); PG8_BAR; PG8_MMA(0, 0, At, B0); PG8_MMA(0, 1, At, B1); PG8_BAR; PG8_SCHED;
            PG8_LDA(At, 1, 1); PG8_STAGE(PG8_SB(1, 0), b2 + kstep, vB); PG8_STAGE(PG8_SB(1, 1), b2h + kstep, vB); PG8_STAGE(PG8_SA(1, 0), a2 + kstep, vA[0]);
            PG8_WAIT_V(8); PG8_WAIT_L(0); PG8_BAR; PG8_MMA(1, 0, At, B0); PG8_MMA(1, 1, At, B1); PG8_BAR; PG8_SCHED;
        }
        if (wr == 0) PG8_BAR;
        if constexpr (Sched::FP8) asm volatile("s_nop 15\n\ts_nop 15" ::: "memory");
        if constexpr (Sched::FP8) {
#pragma unroll
            for (int a = 0; a < 2; ++a)
#pragma unroll
                for (int b = 0; b < (Sched::HALFN ? 1 : 2); ++b) asm volatile("" : "+v"(acc[a][b][0][0]), "+v"(acc[a][b][0][1]), "+v"(acc[a][b][1][0]), "+v"(acc[a][b][1][1]), "+v"(acc[a][b][2][0]), "+v"(acc[a][b][2][1]), "+v"(acc[a][b][3][0]), "+v"(acc[a][b][3][1])); }
        { int tz = threadIdx.x; asm volatile("" : "+v"(tz));
          const int wz = __builtin_amdgcn_readfirstlane(tz >> 6), lz = tz & 63; E(acc, cur, wz >> 2, wz & 3, lz & 15, lz >> 4, (const LAS unsigned char*)(lds + PF_LDS_OFF + (ui & 1) * PF_SLOT)); }
        if (!has_next) break;
#pragma unroll
        for (int a = 0; a < 2; ++a)
#pragma unroll
            for (int b = 0; b < (Sched::HALFN ? 1 : 2); ++b)
#pragma unroll
                for (int m = 0; m < 4; ++m)
#pragma unroll
                    for (int n = 0; n < 2; ++n) acc[a][b][m][n] = (f32x4){0.f, 0.f, 0.f, 0.f};
        cur = nxt; cA = cur.A; cB = cur.B; ++ui;
        if (wr == 1) PG8_BAR;
    }
    PG8_WAIT_V(0);
    PG8_BAR;
#undef PG8_SA
#undef PG8_SB
#undef PG8_STAGE
#undef PG8_LDA
#undef PG8_LDB
#undef PG8_MMA
#undef PG8_LO
#undef PG8_HI
#undef PG8_LD8
#undef PG8_WAIT_V
#undef PG8_WAIT_L
#undef PG8_BAR
#undef PG8_SCHED
#undef PG8_OFFS
#undef HA
#undef HB
#undef VA1
}
}

struct Args { const float* in[N_INPUTS]; float* out; unsigned char* ws; int ph_lo, ph_hi; };

struct Frame {
    LAS unsigned char* lds;
    unsigned char* ws;
    int tid, lane, wave, vcu, G, bx;
};

#define CAS __attribute__((address_space(4)))
__device__ __forceinline__ const float* inp(int i) {
    const CAS char* kp = (const CAS char*)__builtin_amdgcn_kernarg_segment_ptr();
    asm volatile("" : "+s"(kp));
    const unsigned long long v = *(const CAS unsigned long long*)(kp + 8 * i);
    return (const float*)(const GAS float*)v;
}
__device__ __forceinline__ float* outp() {
    const CAS char* kp = (const CAS char*)__builtin_amdgcn_kernarg_segment_ptr();
    asm volatile("" : "+s"(kp));
    const unsigned long long v = *(const CAS unsigned long long*)(kp + 8 * N_INPUTS);
    return (float*)(GAS float*)v;
}
__device__ __forceinline__ unsigned cvt_pk_bf16(float lo, float hi) { unsigned r; asm volatile("v_cvt_pk_bf16_f32 %0, %1, %2" : "=v"(r) : "v"(lo), "v"(hi)); return r; }

template <bool FP8_>
struct SchedDenseT {
    static constexpr bool GATHER = false, FP8 = FP8_, HALFN = false, BADJ = FP8_;
    const char* A; const char* B; unsigned lda, ldb; int nt, nM, nN, G, c; int latonly;
    __device__ __forceinline__ int arow(const gm::GUnit&, int r) const { return r; }
    __device__ __forceinline__ bool next(int i, gm::GUnit& u) const {
        const long L = (long)i * G + c; if (L >= (long)nM * nN) return false;
        int pm, pn; gm::tile_of((int)L, nM, nN, pm, pn);
        if (latonly) pm += 1 + (pm >= 32 ? 1 : 0);
        u.A = A + (size_t)pm * 256 * lda; u.B = B + (size_t)pn * 256 * ldb; u.lda = lda; u.ldb = ldb; u.nt = nt; u.row0 = pm * 256; u.col0 = pn * 256; u.aux = 0; u.nvalid = 256; u.gidx = nullptr;
        return true;
    }
};
typedef SchedDenseT<false> SchedDense;
struct SchedMerge {
    static constexpr bool GATHER = false, FP8 = true, HALFN = true, BADJ = false;
    const char* OA; size_t ostride; const char* WO; int G, c; int latonly;
    __device__ __forceinline__ int arow(const gm::GUnit&, int r) const { return r; }
    __device__ __forceinline__ bool next(int i, gm::GUnit& u) const {
        const int nM = latonly ? 64 : 66;
        const int j = i / 6, sub = i - 6 * j, nh = sub / 3, br = sub - 3 * nh; const long L = (long)j * G + c; if (L >= nM * 4) return false;
        int pm, pn; gm::tile_of((int)L, nM, 4, pm, pn);
        if (latonly) pm += 1 + (pm >= 32 ? 1 : 0);
        u.A = OA + (size_t)br * ostride + (size_t)pm * 256 * 512; u.B = WO + (size_t)br * (1024 * 512) + (size_t)(pn * 256 + nh * 128) * 512; u.lda = 512; u.ldb = 512; u.nt = 4;
        u.row0 = pm * 256; u.col0 = pn * 256 + nh * 128; u.aux = br; u.nvalid = 256; u.gidx = nullptr; return true;
    }
};
struct SchedUp {
    static constexpr bool GATHER = false, FP8 = true, HALFN = false, BADJ = true;
    const char* CQN; const char* WUQ; const char* WUKV; int G, c;
    __device__ __forceinline__ int arow(const gm::GUnit&, int r) const { return r; }
    __device__ __forceinline__ bool next(int i, gm::GUnit& u) const {
        const long L = (long)i * G + c; if (L >= 66 * 7) return false;
        int pm, pn; gm::tile_of((int)L, 66, 7, pm, pn);
        u.lda = 512; u.ldb = 256; u.nt = 2; u.row0 = pm * 256; u.col0 = pn * 256; u.aux = 0; u.nvalid = 256; u.gidx = nullptr;
        if (pn < 3) { u.A = CQN + (size_t)pm * 256 * 512; u.B = WUQ + (size_t)pn * 256 * 256; }
        else { u.A = CQN + (size_t)pm * 256 * 512 + 256; u.B = WUKV + (size_t)(pn - 3) * 256 * 256; }
        return true;
    }
};
template <bool GATHER_, int NTN>
struct SchedMoe {
    static constexpr bool GATHER = GATHER_, FP8 = true, HALFN = false, BADJ = false;
    const LAS int* pref;
    const int* cnt;
    const char* A; const char* W; const int* tok; int G, c; unsigned lda; size_t wstride; int nt; int uoff;
    __device__ __forceinline__ int arow(const gm::GUnit& u, int r) const { return u.gidx[min(r, u.nvalid - 1)] >> 2; }
    __device__ __forceinline__ bool next(int i, gm::GUnit& u) const {
        if (i >= MOE_MAXU) return false;
        const v4i_t d = *(const LAS v4i_t*)((const LAS char*)pref + uoff + i * 16);
        const int e = __builtin_amdgcn_readfirstlane(d.x), mg = __builtin_amdgcn_readfirstlane(d.y), pv = __builtin_amdgcn_readfirstlane(d.z), goff = __builtin_amdgcn_readfirstlane(d.w);
        if (e < 0) return false;
        const int pn = pv >> 16;
        u.nvalid = pv & 0xFFFF; u.gidx = tok + goff;
        u.A = GATHER_ ? A : A + (size_t)mg * 256 * lda; u.lda = lda; u.B = W + (size_t)e * wstride + (size_t)pn * 256 * 1024; u.ldb = 1024; u.nt = nt;
        u.row0 = mg * 256; u.col0 = pn; u.aux = e; return true;
    }
};

#define EPI_ARGS f32x4 (&acc)[2][2][4][2], const gm::GUnit& u, int wr, int wc, int fr, int fq, const LAS unsigned char* pfs
struct EpiBf16 {
    static constexpr bool PF = false;
    bf16* O; int ldc; float scale;
    __device__ __forceinline__ void operator()(EPI_ARGS) const {
        const bool hi8 = fr >= 8;
        const int row0 = u.row0 + wr * 64 + (fr & 7), col0 = u.col0 + wc * 64 + (hi8 ? 32 : 0) + 8 * fq;
#pragma unroll
        for (int ai = 0; ai < 2; ++ai)
#pragma unroll
            for (int m = 0; m < 4; ++m) { bf16* rowp = O + (size_t)(row0 + ai * 128 + m * 16) * ldc + col0;
                u32x4 w[2];
#pragma unroll
                for (int bj = 0; bj < 2; ++bj) { const f32x4 v0 = acc[ai][bj][m][0] * scale, v1 = acc[ai][bj][m][1] * scale;
                    w[bj].x = cvt_pk_bf16(v0[0], v0[1]); w[bj].y = cvt_pk_bf16(v0[2], v0[3]); w[bj].z = cvt_pk_bf16(v1[0], v1[1]); w[bj].w = cvt_pk_bf16(v1[2], v1[3]); }
                const u32x4 x = hi8 ? w[0] : w[1];
                u32x4 y; y.x = dppu<0x128>(x.x); y.y = dppu<0x128>(x.y); y.z = dppu<0x128>(x.z); y.w = dppu<0x128>(x.w);
                *(u32x4*)rowp = hi8 ? y : w[0];
                *(u32x4*)(rowp + (size_t)8 * ldc) = hi8 ? w[1] : y; }
    }
};
struct EpiMerge {
    static constexpr bool PF = false;
    const bf16* RAW; bf16* Y;
    __device__ __forceinline__ void operator()(EPI_ARGS) const {
        const int br = u.aux; const int row0 = u.row0 + wr * 64 + fr, col = u.col0 + wc * 32 + 8 * fq;
        u32x4 gws[8];
#pragma unroll
        for (int q = 0; q < 8; ++q) gws[q] = *(const u32x4*)(RAW + (size_t)(row0 + (q >> 2) * 128 + (q & 3) * 16) * NINP + CGATE + br * 1024 + col);
        asm volatile("" ::: "memory");
#pragma unroll
        for (int ai = 0; ai < 2; ++ai)
#pragma unroll
            for (int m = 0; m < 4; ++m) { const int row = row0 + ai * 128 + m * 16;
                const u32x4 gw = gws[ai * 4 + m];
                const float g[8] = {bflo(gw.x), bfhi(gw.x), bflo(gw.y), bfhi(gw.y), bflo(gw.z), bfhi(gw.z), bflo(gw.w), bfhi(gw.w)};
                f32x4 y0 = acc[ai][1][m][0], y1 = acc[ai][1][m][1];
                if (br == 0) { y0 = (f32x4){0.f, 0.f, 0.f, 0.f}; y1 = y0; }
#pragma unroll
                for (int j = 0; j < 4; ++j) { y0[j] += sigmoidf_(g[j]) * W8_INV * acc[ai][0][m][0][j]; y1[j] += sigmoidf_(g[4 + j]) * W8_INV * acc[ai][0][m][1][j]; }
                acc[ai][1][m][0] = y0; acc[ai][1][m][1] = y1;
                if (br == 2) { u32x4 w; w.x = cvt_pk_bf16(y0[0], y0[1]); w.y = cvt_pk_bf16(y0[2], y0[3]); w.z = cvt_pk_bf16(y1[0], y1[1]); w.w = cvt_pk_bf16(y1[2], y1[3]);
                    *(u32x4*)(Y + (size_t)row * D + col) = w; } }
    }
};
struct EpiWout {
    static constexpr bool PF = false;
    float* X; const float* modl;
    __device__ __forceinline__ void operator()(EPI_ARGS) const {
        const int row0 = u.row0 + wr * 64 + fr, col0 = u.col0 + wc * 32 + 8 * fq;
        const int b = u.row0 / TB, rr = u.row0 - b * TB; const int set = (rr < CTX) ? 2 : b;
        const float* g1 = modl + set * 6144 + 2 * 1024;
#pragma unroll
        for (int bj = 0; bj < 2; ++bj) { const int col = col0 + bj * 128;
            const f32x4 ga = *(const f32x4*)(g1 + col), gb = *(const f32x4*)(g1 + col + 4);
            f32x4 xs[8][2];
#pragma unroll
            for (int q = 0; q < 8; ++q) { const float* xp = X + (size_t)(row0 + (q >> 2) * 128 + (q & 3) * 16) * D + col; xs[q][0] = *(const f32x4*)xp; xs[q][1] = *(const f32x4*)(xp + 4); }
            asm volatile("" ::: "memory");
#pragma unroll
            for (int q = 0; q < 8; ++q) { float* xp = X + (size_t)(row0 + (q >> 2) * 128 + (q & 3) * 16) * D + col;
                *(f32x4*)xp = xs[q][0] + ga * acc[q >> 2][bj][q & 3][0]; *(f32x4*)(xp + 4) = xs[q][1] + gb * acc[q >> 2][bj][q & 3][1]; } }
    }
};
struct EpiMoe1 {
    static constexpr bool PF = true;
    unsigned char* ACT; const float* bgu;
    __device__ __forceinline__ void prefetch(const gm::GUnit& u, LAS unsigned char* slot, int lane) const {
        const float* src = bgu + (size_t)u.aux * 2048 + ((lane < 32) ? 0 : 1024) + u.col0 * 128 + (lane & 31) * 4;
        __builtin_amdgcn_global_load_lds((const unsigned*)src, (LAS unsigned*)slot, 16, 0, 0); }
    __device__ __forceinline__ void operator()(EPI_ARGS) const {
        const int e = u.aux, pn = u.col0; const int row0 = u.row0 + wr * 64 + fr, c0 = pn * 128 + wc * 32 + 8 * fq; (void)e;
        const LAS float* bs = (const LAS float*)pfs + wc * 32 + 8 * fq;
        const f32x4 bg0 = *(const LAS f32x4*)bs, bg1 = *(const LAS f32x4*)(bs + 4), bl0 = *(const LAS f32x4*)(bs + 128), bl1 = *(const LAS f32x4*)(bs + 132);
#pragma unroll
        for (int ai = 0; ai < 2; ++ai)
#pragma unroll
            for (int m = 0; m < 4; ++m) {
                float v[8];
#pragma unroll
                for (int n = 0; n < 2; ++n)
#pragma unroll
                    for (int j = 0; j < 4; ++j) {
                        float glu = acc[ai][0][m][n][j] * W8_INV + (n ? bg1[j] : bg0[j]); float lin = acc[ai][1][m][n][j] * W8_INV + (n ? bl1[j] : bl0[j]);
                        glu = fminf(glu, 7.0f); lin = fminf(fmaxf(lin, -7.0f), 7.0f);
                        v[n * 4 + j] = glu * sigmoidf_(1.702f * glu) * (lin + 1.0f); }
                u32x2 w; w.x = pk4_fp8(v[0], v[1], v[2], v[3]); w.y = pk4_fp8(v[4], v[5], v[6], v[7]);
                *(u32x2*)(ACT + (size_t)(row0 + ai * 128 + m * 16) * D + c0) = w; }
    }
};
struct EpiMoe2 {
    static constexpr bool PF = false;
    bf16* OUTA; const float* bdn; const float* wl; const int* tok;
    __device__ __forceinline__ void operator()(EPI_ARGS) const {
        const int e = u.aux; const int rl0 = wr * 64 + fr, col0 = u.col0 * 256 + wc * 32 + 8 * fq;
        const float* wlu = wl + (u.gidx - tok);
        const float* bp = bdn + (size_t)e * 1024 + col0;
        const f32x4 b00 = *(const f32x4*)bp, b01 = *(const f32x4*)(bp + 4), b10 = *(const f32x4*)(bp + 128), b11 = *(const f32x4*)(bp + 132);
        int aidv[8]; float wv[8];
#pragma unroll
        for (int q = 0; q < 8; ++q) { const int rlc = min(rl0 + (q >> 2) * 128 + (q & 3) * 16, u.nvalid - 1); aidv[q] = u.gidx[rlc]; wv[q] = wlu[rlc]; }
        asm volatile("" ::: "memory");
#pragma unroll
        for (int ai = 0; ai < 2; ++ai)
#pragma unroll
            for (int m = 0; m < 4; ++m) { const int rl = rl0 + ai * 128 + m * 16;
                if (rl < u.nvalid) { const int aid = aidv[ai * 4 + m]; const float w = wv[ai * 4 + m]; bf16* op = OUTA + (size_t)aid * D + col0;
                    { const f32x4 v0 = (acc[ai][0][m][0] * W8_INV + b00) * w, v1 = (acc[ai][0][m][1] * W8_INV + b01) * w;
                      u32x4 o; o.x = cvt_pk_bf16(v0[0], v0[1]); o.y = cvt_pk_bf16(v0[2], v0[3]); o.z = cvt_pk_bf16(v1[0], v1[1]); o.w = cvt_pk_bf16(v1[2], v1[3]); *(u32x4*)op = o; }
                    { const f32x4 v0 = (acc[ai][1][m][0] * W8_INV + b10) * w, v1 = (acc[ai][1][m][1] * W8_INV + b11) * w;
                      u32x4 o; o.x = cvt_pk_bf16(v0[0], v0[1]); o.y = cvt_pk_bf16(v0[2], v0[3]); o.z = cvt_pk_bf16(v1[0], v1[1]); o.w = cvt_pk_bf16(v1[2], v1[3]); *(u32x4*)(op + 128) = o; } } }
    }
};

namespace at {
__device__ __forceinline__ int crow(int r, int hi) { return (r & 3) + 8 * (r >> 2) + 4 * hi; }
__device__ __forceinline__ void glds16(const void* gsrc, unsigned lds_dst) { unsigned keep;
    asm volatile("s_mov_b32 %0, m0\n\ts_mov_b32 m0, %2\n\ts_nop 0\n\tglobal_load_lds_dwordx4 %1, off\n\ts_mov_b32 m0, %0" : "=&s"(keep) : "v"(gsrc), "s"(lds_dst) : "memory"); }
typedef float f32x2_t __attribute__((ext_vector_type(2))); typedef __bf16 bf16x2_t __attribute__((ext_vector_type(2)));
__device__ __forceinline__ unsigned cvtpk_s(float lo, float hi) { f32x2_t v = {lo, hi}; bf16x2_t b = __builtin_convertvector(v, bf16x2_t); return __builtin_bit_cast(unsigned, b); }
#define AT_SBAR() __builtin_amdgcn_sched_barrier(0)
typedef short v4i16_t __attribute__((ext_vector_type(4)));
struct Tens8 { const unsigned char* Q; int qp; const unsigned char* K; int kp; const unsigned char* Vt; unsigned char* O; };
__device__ __forceinline__ void attn_unit_f8d(LAS unsigned char* lds, const Tens8& tn, int NT, float negM, float lam, const float* subg, float subscale) {
    constexpr int NS = 8, KS = 4096, VS = 4096;
    constexpr int LDS_K = 0, LDS_V = NS * KS, LDS_WS = LDS_V + NS * VS, LDS_OST = LDS_WS + 8 * 512;
    int tid = threadIdx.x; asm volatile("" : "+v"(tid));
    const int lane = tid & 63, r32 = lane & 31, hi = lane >> 5; const int wid = __builtin_amdgcn_readfirstlane(tid >> 6);
    const unsigned lds0 = (unsigned)(size_t)lds;
    const int kc = wid & 3, vc = wid & 3;
    const unsigned kvoff = (wid < 4) ? (unsigned)(lane * tn.kp + kc * 16) : (unsigned)(lane * TB + vc * 16);
    const unsigned kdst = lds0 + LDS_K + kc * 1024, vdst = lds0 + LDS_V + vc * 1024;
    const int NTm1 = NT - 1;
#define FD_DMA_K(j, s) do { const int j_ = min((j), NTm1); glds16(tn.K + (size_t)j_ * 64 * tn.kp + kvoff, (unsigned)__builtin_amdgcn_readfirstlane(kdst + (s) * KS)); } while (0)
#define FD_DMA_V(j, s) do { const int j_ = min((j), NTm1); glds16(tn.Vt + (size_t)j_ * 64 + kvoff, (unsigned)__builtin_amdgcn_readfirstlane(vdst + (s) * VS)); } while (0)
#define FD_PAIR(jk, sk, jv, sv) do { if (wid < 4) FD_DMA_K(jk, sk); else FD_DMA_V(jv, sv); } while (0)
#define FD_WAITBAR() asm volatile("s_waitcnt vmcnt(6) lgkmcnt(0)\n\ts_barrier" ::: "memory")
    const LAS unsigned char* kp0 = lds + LDS_K + (2 * hi) * 1024 + r32 * 16;
    const LAS unsigned char* vp0 = kp0 + (LDS_V - LDS_K);
#define FD_LD8(p) __builtin_shufflevector(*(const LAS v4i_t*)(p), *(const LAS v4i_t*)((p) + 1024), 0, 1, 2, 3, 4, 5, 6, 7)
#define FD_LD6(p) __builtin_shufflevector(*(const LAS v4i_t*)(p), __builtin_shufflevector(*(const LAS v2i_t*)((p) + 1024), *(const LAS v2i_t*)((p) + 1024), 0, 1, -1, -1), 0, 1, 2, 3, 4, 5)
    const unsigned char* Qw = tn.Q + (size_t)(wid * 32 + r32) * tn.qp + 32 * hi;
    const v4i_t qx0 = *(const v4i_t*)(Qw); const v2i_t qx1 = *(const v2i_t*)(Qw + 16);
    v6i_t qm[2];
    { const int z0 = (hi == 0) ? -1 : 0, z1 = (hi == 1) ? -1 : 0;
      qm[0] = (v6i_t){qx0.x & z0, qx0.y & z0, qx0.z & z0, qx0.w & z0, qx1.x & z0, qx1.y & z0}; qm[1] = (v6i_t){qx0.x & z1, qx0.y & z1, qx0.z & z1, qx0.w & z1, qx1.x & z1, qx1.y & z1};
      asm volatile("" : "+v"(qm[0]), "+v"(qm[1])); }
    if (wid < 4) { FD_DMA_K(0, 0); FD_DMA_K(1, 1); }
#pragma unroll
    for (int j = 0; j < NS - 2; ++j) FD_PAIR(j + 2, j + 2, j, j);
    f32x16 negm;
#pragma unroll
    for (int r = 0; r < 16; ++r) negm[r] = negM;
    f32x16 o1[2], o2[2]; o1[0] = f32x16{}; o1[1] = f32x16{}; o2[0] = f32x16{}; o2[1] = f32x16{};
    f32x4 os1 = f32x4{}, os2 = f32x4{};
    v8i_t ones;
    { const int ov_ = ((((lane >> 4) & 1) != 0) == ((lane & 15) >= 8)) ? 0x38383838 : 0;
#pragma unroll
      for (int i = 0; i < 8; ++i) ones[i] = ov_; }
    v6i_t kf[2];
#define FD_KLD(ksl) do { kf[0] = FD_LD6(kp0 + (ksl) * KS); kf[1] = FD_LD6(kp0 + (ksl) * KS + 512); } while (0)
    FD_WAITBAR();
    FD_KLD(0);
    asm volatile("s_waitcnt lgkmcnt(0)\n\ts_barrier" ::: "memory");
    FD_PAIR(NS, 0, NS - 2, NS - 2);
    f32x16 c0, c1, e0, e1;
    v8i_t vf[2], pw1, pw2;
    int sc1 = 0x7F7F7F7F, scK = 0x7E7E7E7E, scQ = 0x77777777; asm volatile("" : "+v"(sc1), "+v"(scK), "+v"(scQ));
#define FD_PAD() asm volatile("s_nop 15\n\ts_nop 15" ::: "memory")
#define FD_KEEP2(a, b) asm volatile("" :: "v"(a), "v"(b))
#define FD_TIE2(a, b) asm volatile("" : "+v"(a), "+v"(b))
#define FD_PADT2(a, b) asm volatile("s_nop 15\n\ts_nop 15" : "+v"(a), "+v"(b))
#define FD_QKF(C, K6, Q6) asm volatile("v_mfma_scale_f32_32x32x64_f8f6f4 %0, %1, %2, %3, %4, %5 op_sel_hi:[0,0,0] cbsz:2 blgp:2" : "=&v"(C) : "v"(K6), "v"(Q6), "v"(negm), "v"(scK), "v"(scQ))
#define FD_ACC(O, PW, V) asm volatile("v_mfma_scale_f32_32x32x64_f8f6f4 %0, %1, %2, %0, %3, %3 op_sel_hi:[0,0,0]" : "+v"(O) : "v"(PW), "v"(V), "v"(sc1))
#define FD_SUM(OS, PW) asm volatile("v_mfma_scale_f32_16x16x128_f8f6f4 %0, %1, %2, %0, %3, %3 op_sel_hi:[0,0,0]" : "+v"(OS) : "v"(PW), "v"(ones), "v"(sc1))
#define FD_CV(PW, C0, C1, w_) do { int a_ = (int)codes4(C0[4 * (w_)], C0[4 * (w_) + 1], C0[4 * (w_) + 2], C0[4 * (w_) + 3]), b_ = (int)codes4(C1[4 * (w_)], C1[4 * (w_) + 1], C1[4 * (w_) + 2], C1[4 * (w_) + 3]); \
        asm volatile("" : "+v"(a_), "+v"(b_));   PW[w_] = a_; PW[4 + (w_)] = b_; } while (0)
    { FD_QKF(c0, kf[0], qm[0]); FD_QKF(c1, kf[1], qm[0]); FD_QKF(e0, kf[0], qm[1]); FD_QKF(e1, kf[1], qm[1]); AT_SBAR(); FD_KLD(1); FD_PADT2(c0, c1);
      FD_CV(pw1, c0, c1, 0); FD_CV(pw1, c0, c1, 1); FD_CV(pw1, c0, c1, 2); FD_CV(pw1, c0, c1, 3); AT_SBAR();
      FD_WAITBAR();
      FD_PAIR(NS + 1, 1, NS - 1, NS - 1); }
    for (int t = 1; t < NT; ++t) {
        const LAS unsigned char* vp_ = vp0 + ((t - 1) & (NS - 1)) * VS;
        vf[0] = FD_LD8(vp_); vf[1] = FD_LD8(vp_ + 512); AT_SBAR();
        FD_TIE2(e0, e1); FD_QKF(c0, kf[0], qm[0]); AT_SBAR(); FD_CV(pw2, e0, e1, 0); AT_SBAR(); FD_QKF(c1, kf[1], qm[0]); AT_SBAR(); FD_CV(pw2, e0, e1, 1); AT_SBAR();
        FD_ACC(o1[0], pw1, vf[0]); AT_SBAR(); FD_CV(pw2, e0, e1, 2); AT_SBAR(); FD_ACC(o1[1], pw1, vf[1]); AT_SBAR(); FD_CV(pw2, e0, e1, 3); AT_SBAR(); FD_SUM(os1, pw1); AT_SBAR();
        FD_QKF(e0, kf[0], qm[1]); FD_QKF(e1, kf[1], qm[1]); AT_SBAR(); FD_TIE2(c0, c1); FD_CV(pw1, c0, c1, 0); AT_SBAR();
        FD_ACC(o2[0], pw2, vf[0]); AT_SBAR(); FD_KEEP2(kf[0], kf[1]); FD_KLD((t + 1) & (NS - 1)); FD_CV(pw1, c0, c1, 1); FD_CV(pw1, c0, c1, 2); AT_SBAR(); FD_ACC(o2[1], pw2, vf[1]); AT_SBAR(); FD_CV(pw1, c0, c1, 3); AT_SBAR(); FD_SUM(os2, pw2); AT_SBAR();
        FD_WAITBAR();
        FD_PAIR(t + 1 + NS, (t + 1) & (NS - 1), t - 1 + NS, (t - 1) & (NS - 1));
        FD_KEEP2(vf[0], vf[1]); FD_KEEP2(pw1, pw2);
    }
    { const LAS unsigned char* vp_ = vp0 + ((NT - 1) & (NS - 1)) * VS; vf[0] = FD_LD8(vp_); vf[1] = FD_LD8(vp_ + 512); AT_SBAR();
      FD_TIE2(e0, e1); FD_CV(pw2, e0, e1, 0); FD_CV(pw2, e0, e1, 1); FD_CV(pw2, e0, e1, 2); FD_CV(pw2, e0, e1, 3); AT_SBAR();
      FD_ACC(o1[0], pw1, vf[0]); FD_ACC(o1[1], pw1, vf[1]); FD_SUM(os1, pw1); FD_ACC(o2[0], pw2, vf[0]); FD_ACC(o2[1], pw2, vf[1]); FD_SUM(os2, pw2);
      asm volatile("s_nop 15\n\ts_nop 15" : "+v"(o1[0]), "+v"(o1[1]), "+v"(o2[0]), "+v"(o2[1]), "+v"(os1), "+v"(os2)); }
    float val[2][16];
    { LAS float* sm = (LAS float*)(lds + LDS_OST + wid * 2048);
        if ((lane & 7) == 0) { const int sb_ = ((lane & 8) ? 16 : 0) + 4 * (lane >> 4); *(LAS f32x4*)(sm + sb_) = os1; *(LAS f32x4*)(sm + 32 + sb_) = os2; }
        asm volatile("s_waitcnt lgkmcnt(0)" ::: "memory");
#pragma unroll
        for (int k = 0; k < 4; ++k) { const f32x4 t1 = *(const LAS f32x4*)(sm + 8 * k + 4 * hi), t2 = *(const LAS f32x4*)(sm + 32 + 8 * k + 4 * hi);
#pragma unroll
            for (int j = 0; j < 4; ++j) { const int r = 4 * k + j; const float rl1 = __builtin_amdgcn_rcpf(t1[j]); const float rl2 = lam * __builtin_amdgcn_rcpf(t2[j]);
                val[0][r] = o1[0][r] * rl1 - o2[0][r] * rl2; val[1][r] = o1[1][r] * rl1 - o2[1][r] * rl2; } }
        asm volatile("s_waitcnt lgkmcnt(0)" ::: "memory"); }
    { const float g0 = subg[r32] * subscale, g1 = subg[32 + r32] * subscale;
#pragma unroll
        for (int r = 0; r < 16; ++r) { float s = val[0][r] * val[0][r] + val[1][r] * val[1][r];
#pragma unroll
            for (int o = 1; o < 32; o <<= 1) s += shflx(s, o);
            const float rs = rsqrtf(s * (1.0f / 64.0f) + NORM_EPS); val[0][r] *= rs * g0; val[1][r] *= rs * g1; } }
    { LAS unsigned char* stg = lds + LDS_OST + wid * 2048;
#pragma unroll
        for (int r = 0; r < 16; ++r) { const int orow = crow(r, hi); const unsigned w2 = pk4_fp8(val[0][r], val[1][r], 0.f, 0.f);
            stg[orow * 64 + r32] = (unsigned char)w2; stg[orow * 64 + 32 + r32] = (unsigned char)(w2 >> 8); }
        asm volatile("s_waitcnt lgkmcnt(0)" ::: "memory");
        unsigned char* Ow = tn.O + (size_t)(wid * 32) * 512;
        { const int row = lane >> 1, hf = lane & 1; const u32x4 v0 = *(const LAS u32x4*)(stg + row * 64 + hf * 32), v1 = *(const LAS u32x4*)(stg + row * 64 + hf * 32 + 16);
          *(u32x4*)(Ow + (size_t)row * 512 + hf * 32) = v0; *(u32x4*)(Ow + (size_t)row * 512 + hf * 32 + 16) = v1; } }
    asm volatile("s_waitcnt lgkmcnt(0)\n\ts_barrier" ::: "memory");
#undef FD_DMA_K
#undef FD_DMA_V
#undef FD_PAIR
#undef FD_WAITBAR
#undef FD_LD8
#undef FD_LD6
#undef FD_KLD
#undef FD_PAD
#undef FD_KEEP2
#undef FD_TIE2
#undef FD_PADT2
#undef FD_QKF
#undef FD_ACC
#undef FD_SUM
#undef FD_CV
}

template <int KB, bool DIFF, bool F4 = false, int NQB = 1>
__device__ __forceinline__ void attn_unit_x2(LAS unsigned char* lds, const Tens8& tn, int NT, float negM, float lam, const float* subg, float subscale, size_t qbs = 0, size_t obs = 0) {
    constexpr int NS = 4, KS = KB * 64, VS = 4096, KS2 = 2 * KS, VS2 = 2 * VS, NKM = F4 ? KB / 32 : KB / 64;
    constexpr int LDS_K = 0, LDS_V = NS * KS2, LDS_OST = 0;
    static_assert(LDS_V + NS * VS2 <= RING_BYTES && NS * KS2 >= 8 * 2048 && !(F4 && DIFF), "attention LDS");
    int tid = threadIdx.x; asm volatile("" : "+v"(tid));
    const int lane = tid & 63, r32 = lane & 31, hi = lane >> 5; const int wid = __builtin_amdgcn_readfirstlane(tid >> 6);
    const unsigned lds0 = (unsigned)(size_t)lds;
    const int vsub = wid >> 2, vc = wid & 3;
    const unsigned voff = (unsigned)(lane * TB + vsub * 64 + vc * 16), vdst = lds0 + LDS_V + vsub * VS + vc * 1024;
    const int ksub = (KB == 64) ? (wid >> 2) : (KB == 32) ? ((wid >> 1) & 1) : 0, kc = (KB == 64) ? (wid & 3) : (KB == 32) ? (wid & 1) : wid;
    const unsigned koff = (unsigned)((ksub * 64 + lane) * tn.kp + kc * 16), kdst = lds0 + LDS_K + ksub * KS + kc * 1024;
    const int NST = NT >> 1, NTm1 = NT - 1;
#define X2_DMA_K(j, sl) do { if (KB == 32) { if (wid < 4) { const int tt_ = min(2 * (j) + ksub, NTm1) - ksub; glds16(tn.K + (size_t)tt_ * 64 * tn.kp + koff, (unsigned)__builtin_amdgcn_readfirstlane(kdst + (sl) * KS2)); } } \
        else if (KB == 64) { const int tt_ = min(2 * (j) + ksub, NTm1) - ksub; glds16(tn.K + (size_t)tt_ * 64 * tn.kp + koff, (unsigned)__builtin_amdgcn_readfirstlane(kdst + (sl) * KS2)); } \
        else { const int t0_ = min(2 * (j), NTm1), t1_ = min(2 * (j) + 1, NTm1); glds16(tn.K + (size_t)t0_ * 64 * tn.kp + koff, (unsigned)__builtin_amdgcn_readfirstlane(kdst + (sl) * KS2)); \
               glds16(tn.K + (size_t)t1_ * 64 * tn.kp + koff, (unsigned)__builtin_amdgcn_readfirstlane(kdst + (sl) * KS2 + KS)); } } while (0)
#define X2_DMA_V(j, sl) do { const int tt_ = min(2 * (j) + vsub, NTm1) - vsub; glds16(tn.Vt + (size_t)tt_ * 64 + voff, (unsigned)__builtin_amdgcn_readfirstlane(vdst + (sl) * VS2)); } while (0)
#define X2_PAIR(p) do { X2_DMA_K((p), (p) & (NS - 1)); X2_DMA_V((p) - 1, ((p) - 1) & (NS - 1)); } while (0)
#define X2_WAITBAR() do { if (KB == 64 || (KB == 32 && wid < 4)) asm volatile("s_waitcnt vmcnt(2) lgkmcnt(0)\n\ts_barrier" ::: "memory"); else if (KB == 32) asm volatile("s_waitcnt vmcnt(1) lgkmcnt(0)\n\ts_barrier" ::: "memory"); \
        else asm volatile("s_waitcnt vmcnt(3) lgkmcnt(0)\n\ts_barrier" ::: "memory"); } while (0)
    const LAS unsigned char* kp0 = lds + LDS_K + (F4 ? hi : 2 * hi) * 1024 + r32 * 16;
    const LAS unsigned char* vp0 = lds + LDS_V + (2 * hi) * 1024 + r32 * 16;
#define X2_LD4(p) __builtin_shufflevector(*(const LAS v4i_t*)(p), *(const LAS v4i_t*)(p), 0, 1, 2, 3, -1, -1, -1, -1)
#define X2_LD8(p) __builtin_shufflevector(*(const LAS v4i_t*)(p), *(const LAS v4i_t*)((p) + 1024), 0, 1, 2, 3, 4, 5, 6, 7)
    const unsigned char* Qw = tn.Q + (size_t)(wid * 32 + r32) * tn.qp + (F4 ? 16 : 32) * hi;
    constexpr int NQ = DIFF ? 2 : NKM;
    v8i_t qr[NQ];
    v4i_t qr4[F4 ? NQB * NKM : 1];
    if constexpr (F4) {
#pragma unroll
        for (int j = 0; j < NQB; ++j)
#pragma unroll
            for (int m = 0; m < NKM; ++m) { qr4[j * NKM + m] = *(const v4i_t*)(Qw + (size_t)j * qbs + 32 * m); asm volatile("" :: "v"(qr4[j * NKM + m])); } }
    else if constexpr (DIFF) { const v8i_t qx = __builtin_shufflevector(*(const v4i_t*)(Qw), *(const v4i_t*)(Qw + 16), 0, 1, 2, 3, 4, 5, 6, 7);
#pragma unroll
        for (int i = 0; i < 8; ++i) { qr[0][i] = (hi == 0) ? qx[i] : 0; qr[1][i] = (hi == 1) ? qx[i] : 0; } }
    else {
#pragma unroll
        for (int m = 0; m < NKM; ++m) qr[m] = __builtin_shufflevector(*(const v4i_t*)(Qw + 64 * m), *(const v4i_t*)(Qw + 64 * m + 16), 0, 1, 2, 3, 4, 5, 6, 7); }
    if constexpr (!F4) {
#pragma unroll
        for (int m = 0; m < NQ; ++m) asm volatile("" :: "v"(qr[m])); }
    X2_DMA_K(0, 0);
#pragma unroll
    for (int p = 1; p < NS - 1; ++p) X2_PAIR(p);
    f32x16 negm;
#pragma unroll
    for (int r = 0; r < 16; ++r) negm[r] = negM;
    f32x16 o1[2], os1; o1[0] = f32x16{}; o1[1] = f32x16{}; os1 = f32x16{};
    f32x16 o2[2], os2; if (DIFF) { o2[0] = f32x16{}; o2[1] = f32x16{}; os2 = f32x16{}; }
    v8i_t ones;
    if constexpr (DIFF) {
#pragma unroll
        for (int i = 0; i < 8; ++i) ones[i] = 0x38383838; }
    else { const int ov_ = ((((lane >> 4) & 1) != 0) == ((lane & 15) >= 8)) ? 0x38383838 : 0;
#pragma unroll
        for (int i = 0; i < 8; ++i) ones[i] = ov_; }
    f32x4 os4 = f32x4{};
    f32x16 oq[F4 ? NQB : 1][2]; f32x4 osq[F4 ? NQB : 1];
#pragma unroll
    for (int j = 0; j < (F4 ? NQB : 1); ++j) { oq[j][0] = f32x16{}; oq[j][1] = f32x16{}; osq[j] = f32x4{}; }
    constexpr int NKF = DIFF ? 2 : 2 * NKM;
    v8i_t kf[F4 ? 1 : NKF];
    v4i_t kf4[F4 ? NKF : 1];
#define X2_KLD(sl, sub) do { const LAS unsigned char* kb_ = kp0 + (sl) * KS2 + (sub) * KS; if constexpr (DIFF) { kf[0] = X2_LD8(kb_); kf[1] = X2_LD8(kb_ + 512); } \
        else if constexpr (F4) { _Pragma("unroll") for (int h_ = 0; h_ < 2; ++h_) _Pragma("unroll") for (int m_ = 0; m_ < NKM; ++m_) kf4[h_ * NKM + m_] = *(const LAS v4i_t*)(kb_ + m_ * 2048 + h_ * 512); } \
        else { _Pragma("unroll") for (int h_ = 0; h_ < 2; ++h_) _Pragma("unroll") for (int m_ = 0; m_ < NKM; ++m_) kf[h_ * NKM + m_] = X2_LD8(kb_ + m_ * 4096 + h_ * 512); } } while (0)
#define X2_VLD(sl, sub) do { const LAS unsigned char* vb_ = vp0 + (sl) * VS2 + (sub) * VS; vf[0] = X2_LD8(vb_); vf[1] = X2_LD8(vb_ + 512); } while (0)
    X2_WAITBAR();
    X2_KLD(0, 0);
    asm volatile("s_waitcnt lgkmcnt(0)\n\ts_barrier" ::: "memory");
    X2_PAIR(NS - 1);
    f32x16 c0, c1;
    v8i_t vf[2], pw1, pw2;
#define X2_MF(a, b, c, fa) __builtin_amdgcn_mfma_scale_f32_32x32x64_f8f6f4(a, b, c, fa, 0, 0, 0x7F7F7F7F, 0, 0x7F7F7F7F)
#define X2_QK(mp) do { if constexpr (DIFF) { c0 = X2_MF(kf[0], qr[mp], negm, 0); c1 = X2_MF(kf[1], qr[mp], negm, 0); } \
        else { _Pragma("unroll") for (int m_ = 0; m_ < NKM; ++m_) { c0 = X2_MF(kf[m_], qr[m_], (m_ == 0) ? negm : c0, 0); c1 = X2_MF(kf[NKM + m_], qr[m_], (m_ == 0) ? negm : c1, 0); } } } while (0)
#define X2_CVT(PW) do { _Pragma("unroll") for (int w_ = 0; w_ < 4; ++w_) { unsigned a_ = 0u, b_ = 0u; \
        _Pragma("unroll") for (int j_ = 0; j_ < 4; ++j_) { a_ = __builtin_amdgcn_cvt_pk_u8_f32(c0[4 * w_ + j_], j_, a_); b_ = __builtin_amdgcn_cvt_pk_u8_f32(c1[4 * w_ + j_], j_, b_); } \
        PW[w_] = (int)a_; PW[4 + w_] = (int)b_; } } while (0)
#define X2_PV(PW, O, OS) do { O[0] = X2_MF(PW, vf[0], O[0], DIFF ? 0 : 1); O[1] = X2_MF(PW, vf[1], O[1], DIFF ? 0 : 1); OS = X2_MF(PW, ones, OS, DIFF ? 0 : 1); } while (0)
#define X2_SUB(FIRST, psl, psub, nsl, nsub) do { \
        if (!(FIRST)) { X2_VLD(psl, psub); AT_SBAR(); } \
        X2_QK(0); AT_SBAR(); \
        if (!(FIRST)) { X2_PV(pw1, o1, os1); AT_SBAR(); } \
        if constexpr (DIFF) { X2_CVT(pw1); AT_SBAR(); X2_QK(1); AT_SBAR(); if (!(FIRST)) { X2_PV(pw2, o2, os2); AT_SBAR(); } X2_KLD(nsl, nsub); X2_CVT(pw2); AT_SBAR(); } \
        else { X2_KLD(nsl, nsub); X2_CVT(pw1); AT_SBAR(); } } while (0)
    if constexpr (DIFF) {
    X2_SUB(true, 0, 0, 0, 1);
    X2_SUB(false, 0, 0, 1, 0);
    X2_WAITBAR(); X2_PAIR(NS);
    for (int u = 1; u < NST; ++u) {
        const int su = u & (NS - 1), sp = (u - 1) & (NS - 1), sn = (u + 1) & (NS - 1);
        X2_SUB(false, sp, 1, su, 1);
        X2_SUB(false, su, 0, sn, 0);
        X2_WAITBAR(); X2_PAIR(u + NS);
    }
    { X2_VLD((NST - 1) & (NS - 1), 1); X2_PV(pw1, o1, os1); X2_PV(pw2, o2, os2); }
    } else {
    f32x16 d0, d1;
    int sc1 = 0x7F7F7F7F, scK = 0x7E7E7E7E, scQ = 0x76767676; asm volatile("" : "+v"(sc1), "+v"(scK), "+v"(scQ));
#define X2_PAD() asm volatile("s_nop 15\n\ts_nop 15" ::: "memory")
#define X2_KEEPV() asm volatile("" :: "v"(vf[0]), "v"(vf[1]))
#define X2_TIE2(a, b) do { if constexpr (F4) asm volatile("" : "+v"(a), "+v"(b)); } while (0)
#define X2_PADT2(a, b) asm volatile("s_nop 15\n\ts_nop 15" : "+v"(a), "+v"(b))
#define X2_KEEPP() asm volatile("" :: "v"(pw1))
#define X2_KEEPK() do { if constexpr (F4) { _Pragma("unroll") for (int i_ = 0; i_ < NKF; ++i_) asm volatile("" :: "v"(kf4[i_])); } } while (0)
#define X2A_QKF(C, K4, Q4) asm volatile("v_mfma_scale_f32_32x32x64_f8f6f4 %0, %1, %2, %3, %4, %5 op_sel_hi:[0,0,0] cbsz:4 blgp:4" : "=&v"(C) : "v"(K4), "v"(Q4), "v"(negm), "v"(scK), "v"(scQ))
#define X2A_QKA(C, K4, Q4) asm volatile("v_mfma_scale_f32_32x32x64_f8f6f4 %0, %1, %2, %0, %3, %4 op_sel_hi:[0,0,0] cbsz:4 blgp:4" : "+v"(C) : "v"(K4), "v"(Q4), "v"(scK), "v"(scQ))
#define X2A_PV(O, PW, V) asm volatile("v_mfma_scale_f32_32x32x64_f8f6f4 %0, %1, %2, %0, %3, %3 op_sel_hi:[0,0,0] cbsz:1" : "+v"(O) : "v"(PW), "v"(V), "v"(sc1))
#define X2A_SUM(OS, PW) asm volatile("v_mfma_scale_f32_16x16x128_f8f6f4 %0, %1, %2, %0, %3, %3 op_sel_hi:[0,0,0] cbsz:1" : "+v"(OS) : "v"(PW), "v"(ones), "v"(sc1))
#define X2_PVS(PW) do { if constexpr (F4) { X2A_PV(o1[0], PW, vf[0]); X2A_PV(o1[1], PW, vf[1]); X2A_SUM(os4, PW); } \
        else { o1[0] = X2_MF(PW, vf[0], o1[0], 1); o1[1] = X2_MF(PW, vf[1], o1[1], 1); os4 = __builtin_amdgcn_mfma_scale_f32_16x16x128_f8f6f4(PW, ones, os4, 1, 0, 0, 0x7F7F7F7F, 0, 0x7F7F7F7F); } } while (0)
#define X2_MFS(a, b, c) (F4 ? __builtin_amdgcn_mfma_scale_f32_32x32x64_f8f6f4(a, b, c, 4, 4, 0, 0x7E7E7E7E, 0, 0x76767676)   \
                            : __builtin_amdgcn_mfma_scale_f32_32x32x64_f8f6f4(a, b, c, 0, 0, 0, 0x7F7F7F7F, 0, 0x77777777))
#define X2_QKJ(j_) do { X2A_QKF(c0, kf4[0], qr4[(j_) * NKM]); X2A_QKF(c1, kf4[NKM], qr4[(j_) * NKM]); if constexpr (NKM == 2) { X2A_QKA(c0, kf4[1], qr4[(j_) * NKM + 1]); X2A_QKA(c1, kf4[NKM + 1], qr4[(j_) * NKM + 1]); } } while (0)
#define X2_QKB(C0, C1) do { if constexpr (F4) { X2A_QKF(C0, kf4[0], qr4[0]); X2A_QKF(C1, kf4[NKM], qr4[0]); if constexpr (NKM == 2) { X2A_QKA(C0, kf4[1], qr4[1]); X2A_QKA(C1, kf4[NKM + 1], qr4[1]); } } \
        else { _Pragma("unroll") for (int m_ = 0; m_ < NKM; ++m_) { C0 = X2_MFS(kf[m_], qr[m_], (m_ == 0) ? negm : C0); C1 = X2_MFS(kf[NKM + m_], qr[m_], (m_ == 0) ? negm : C1); } } } while (0)
#define X2_CVTB(C0, C1) do { _Pragma("unroll") for (int w_ = 0; w_ < 4; ++w_) { pw1[w_] = (int)codes4(C0[4 * w_], C0[4 * w_ + 1], C0[4 * w_ + 2], C0[4 * w_ + 3]); \
        pw1[4 + w_] = (int)codes4(C1[4 * w_], C1[4 * w_ + 1], C1[4 * w_ + 2], C1[4 * w_ + 3]); } } while (0)
    if constexpr (F4) {
    v8i_t pwq[NQB][2];
#define X2_CV(PW, w_) do { int a_ = (int)codes4(c0[4 * (w_)], c0[4 * (w_) + 1], c0[4 * (w_) + 2], c0[4 * (w_) + 3]), b_ = (int)codes4(c1[4 * (w_)], c1[4 * (w_) + 1], c1[4 * (w_) + 2], c1[4 * (w_) + 3]); \
        asm volatile("" : "+v"(a_), "+v"(b_)); PW[w_] = a_; PW[4 + (w_)] = b_; } while (0)
#define X2_BLK(j_, PPi, PNi, PRE_STMT, MID_STMT) do { __builtin_amdgcn_s_setprio(1); X2_QKJ(j_); AT_SBAR(); PRE_STMT; AT_SBAR(); X2A_PV(oq[j_][0], pwq[j_][PPi], vf[0]); __builtin_amdgcn_s_setprio(0); AT_SBAR(); \
        if constexpr (NKM == 1) asm volatile("s_nop 15\n\ts_nop 5" : "+v"(c0), "+v"(c1) : "v"(pwq[j_][PNi])); else asm volatile("s_nop 15\n\ts_nop 15" : "+v"(c0), "+v"(c1) : "v"(pwq[j_][PNi])); AT_SBAR(); \
        X2_CV(pwq[j_][PNi], 0); X2_CV(pwq[j_][PNi], 1); AT_SBAR(); X2A_PV(oq[j_][1], pwq[j_][PPi], vf[1]); AT_SBAR(); MID_STMT; X2_CV(pwq[j_][PNi], 2); X2_CV(pwq[j_][PNi], 3); AT_SBAR(); X2A_SUM(osq[j_], pwq[j_][PPi]); AT_SBAR(); } while (0)
#define X2_NOP_STMT do { } while (0)
#define X2_SUBT(PPi, PNi, VLD_STMT, KLD_STMT) do { if constexpr (NQB == 1) X2_BLK(0, PPi, PNi, do { X2_KEEPV(); VLD_STMT; } while (0), do { X2_KEEPK(); KLD_STMT; } while (0)); \
        else { X2_BLK(0, PPi, PNi, do { X2_KEEPV(); VLD_STMT; } while (0), X2_NOP_STMT); X2_BLK(NQB - 1, PPi, PNi, X2_NOP_STMT, do { X2_KEEPK(); KLD_STMT; } while (0)); } } while (0)
#pragma unroll
    for (int j = 0; j < NQB; ++j) { X2_QKJ(j); AT_SBAR(); X2_PADT2(c0, c1); X2_CV(pwq[j][0], 0); X2_CV(pwq[j][0], 1); X2_CV(pwq[j][0], 2); X2_CV(pwq[j][0], 3); AT_SBAR(); asm volatile("" : "=v"(pwq[j][1])); }
    X2_KEEPK(); X2_KLD(0, 1); asm volatile("" : "=v"(vf[0]), "=v"(vf[1]));
    X2_SUBT(0, 1, X2_VLD(0, 0), X2_KLD(1, 0));
    X2_WAITBAR(); X2_PAIR(NS);
    for (int u = 1; u < NST; ++u) {
        const int su = u & (NS - 1), sp = (u - 1) & (NS - 1), sn = (u + 1) & (NS - 1);
        X2_SUBT(1, 0, X2_VLD(sp, 1), X2_KLD(su, 1));
        X2_SUBT(0, 1, X2_VLD(su, 0), X2_KLD(sn, 0));
        X2_WAITBAR(); X2_PAIR(u + NS);
    }
    X2_KEEPV(); X2_VLD((NST - 1) & (NS - 1), 1); AT_SBAR();
#pragma unroll
    for (int j = 0; j < NQB; ++j) { X2A_PV(oq[j][0], pwq[j][1], vf[0]); X2A_PV(oq[j][1], pwq[j][1], vf[1]); X2A_SUM(osq[j], pwq[j][1]); }
#pragma unroll
    for (int j = 0; j < NQB; ++j) asm volatile("s_nop 15\n\ts_nop 15" : "+v"(oq[j][0]), "+v"(oq[j][1]), "+v"(osq[j]));
#undef X2_CV
#undef X2_BLK
#undef X2_NOP_STMT
#undef X2_SUBT
    } else {
    X2_QKB(c0, c1); AT_SBAR(); X2_KLD(0, 1);
    X2_QKB(d0, d1); AT_SBAR(); if constexpr (F4) X2_PADT2(c0, c1); X2_CVTB(c0, c1); AT_SBAR(); X2_VLD(0, 0); X2_PVS(pw1); AT_SBAR(); X2_KEEPK(); X2_KLD(1, 0);
    X2_WAITBAR(); X2_PAIR(NS);
    for (int u = 1; u < NST; ++u) {
        const int su = u & (NS - 1), sp = (u - 1) & (NS - 1), sn = (u + 1) & (NS - 1);
        X2_KEEPV(); X2_VLD(sp, 1); AT_SBAR(); __builtin_amdgcn_s_setprio(1); X2_QKB(c0, c1); __builtin_amdgcn_s_setprio(0); AT_SBAR(); X2_KEEPP(); X2_TIE2(d0, d1); X2_CVTB(d0, d1); AT_SBAR(); __builtin_amdgcn_s_setprio(1); X2_PVS(pw1); __builtin_amdgcn_s_setprio(0); AT_SBAR(); X2_KEEPK(); X2_KLD(su, 1);
        X2_KEEPV(); X2_VLD(su, 0); AT_SBAR(); __builtin_amdgcn_s_setprio(1); X2_QKB(d0, d1); __builtin_amdgcn_s_setprio(0); AT_SBAR(); X2_KEEPP(); X2_TIE2(c0, c1); X2_CVTB(c0, c1); AT_SBAR(); __builtin_amdgcn_s_setprio(1); X2_PVS(pw1); __builtin_amdgcn_s_setprio(0); AT_SBAR(); X2_KEEPK(); X2_KLD(sn, 0);
        X2_WAITBAR(); X2_PAIR(u + NS);
    }
    { X2_KEEPV(); if constexpr (F4) X2_PADT2(d0, d1); X2_KEEPP(); X2_CVTB(d0, d1); AT_SBAR(); X2_VLD((NST - 1) & (NS - 1), 1); X2_PVS(pw1); if constexpr (F4) asm volatile("s_nop 15\n\ts_nop 15" : "+v"(o1[0]), "+v"(o1[1]), "+v"(os4)); }
    }
#undef X2_PAD
#undef X2_KEEPV
#undef X2_TIE2
#undef X2_PADT2
#undef X2_KEEPP
#undef X2_KEEPK
#undef X2A_QKF
#undef X2A_QKA
#undef X2A_PV
#undef X2A_SUM
#undef X2_QKB
#undef X2_QKJ
#undef X2_PVS
#undef X2_MFS
#undef X2_CVTB
    }
    asm volatile("s_waitcnt vmcnt(0) lgkmcnt(0)\n\ts_barrier" ::: "memory");
#pragma unroll
    for (int jb = 0; jb < (F4 ? NQB : 1); ++jb) {
    if constexpr (F4) { o1[0] = oq[jb][0]; o1[1] = oq[jb][1]; os4 = osq[jb]; }
    float val[2][16];
    if constexpr (DIFF) {
#pragma unroll
        for (int r = 0; r < 16; ++r) { const float rl1 = __builtin_amdgcn_rcpf(os1[r]); const float rl2 = lam * __builtin_amdgcn_rcpf(os2[r]); val[0][r] = o1[0][r] * rl1 - o2[0][r] * rl2; val[1][r] = o1[1][r] * rl1 - o2[1][r] * rl2; } }
    else { LAS float* sm = (LAS float*)(lds + LDS_OST + wid * 2048);
        if ((lane & 7) == 0) { const int sb_ = ((lane & 8) ? 16 : 0) + 4 * (lane >> 4); *(LAS f32x4*)(sm + sb_) = os4; }
        asm volatile("s_waitcnt lgkmcnt(0)" ::: "memory");
#pragma unroll
        for (int k = 0; k < 4; ++k) { const f32x4 t1 = *(const LAS f32x4*)(sm + 8 * k + 4 * hi);
#pragma unroll
            for (int j = 0; j < 4; ++j) { const int r = 4 * k + j; const float rl1 = __builtin_amdgcn_rcpf(t1[j]); val[0][r] = o1[0][r] * rl1; val[1][r] = o1[1][r] * rl1; } }
        asm volatile("s_waitcnt lgkmcnt(0)" ::: "memory"); }
    if constexpr (DIFF) { const float g0 = subg[r32] * subscale, g1 = subg[32 + r32] * subscale;
#pragma unroll
        for (int r = 0; r < 16; ++r) { float s = val[0][r] * val[0][r] + val[1][r] * val[1][r];
#pragma unroll
            for (int o = 1; o < 32; o <<= 1) s += shflx(s, o);
            const float rs = rsqrtf(s * (1.0f / 64.0f) + NORM_EPS); val[0][r] *= rs * g0; val[1][r] *= rs * g1; } }
    { LAS unsigned char* stg = lds + LDS_OST + wid * 2048;
#pragma unroll
        for (int r = 0; r < 16; ++r) { const int orow = crow(r, hi); const unsigned w2 = pk4_fp8(val[0][r], val[1][r], 0.f, 0.f);
            stg[orow * 64 + r32] = (unsigned char)w2; stg[orow * 64 + 32 + r32] = (unsigned char)(w2 >> 8); }
        asm volatile("s_waitcnt lgkmcnt(0)" ::: "memory");
        unsigned char* Ow = tn.O + (size_t)jb * obs + (size_t)(wid * 32) * 512;
        { const int row = lane >> 1, hf = lane & 1; const u32x4 v0 = *(const LAS u32x4*)(stg + row * 64 + hf * 32), v1 = *(const LAS u32x4*)(stg + row * 64 + hf * 32 + 16);
          *(u32x4*)(Ow + (size_t)row * 512 + hf * 32) = v0; *(u32x4*)(Ow + (size_t)row * 512 + hf * 32 + 16) = v1; } }
    }
    asm volatile("s_waitcnt lgkmcnt(0)\n\ts_barrier" ::: "memory");
#undef X2_DMA_K
#undef X2_DMA_V
#undef X2_PAIR
#undef X2_WAITBAR
#undef X2_LD8
#undef X2_LD4
#undef X2_KLD
#undef X2_VLD
#undef X2_MF
#undef X2_QK
#undef X2_CVT
#undef X2_PV
#undef X2_SUB
}
}

__device__ __forceinline__ void sincos_acc(float af, float& s, float& c) {
    const double a = (double)af; const double n = rint(a * 0.6366197723675814);
    double r = fma(-n, 1.5707963267948966, a); r = fma(-n, 6.123233995736766e-17, r);
    const double r2 = r * r;
    const double sp = r * (1.0 + r2 * (-1.0 / 6 + r2 * (1.0 / 120 + r2 * (-1.0 / 5040 + r2 * (1.0 / 362880 + r2 * (-1.0 / 39916800))))));
    const double cp = 1.0 + r2 * (-0.5 + r2 * (1.0 / 24 + r2 * (-1.0 / 720 + r2 * (1.0 / 40320 + r2 * (-1.0 / 3628800 + r2 * (1.0 / 479001600))))));
    const int q = ((int)n) & 3;
    const double ss = (q == 0) ? sp : (q == 1) ? cp : (q == 2) ? -sp : -cp;
    const double cc = (q == 0) ? cp : (q == 1) ? -sp : (q == 2) ? -cp : sp;
    s = (float)ss; c = (float)cc;
}

__device__ __forceinline__ void cvt_item(const float* W, int ldw, int sg, int kb, bf16* dst, int K, int g, LAS float* scr, int lane) {
    const int k0 = kb * 64;
    f32x4 v[8];
    if (sg >= 0) {
#pragma unroll
        for (int i = 0; i < 8; ++i) { const int kk = i * 8 + (lane >> 3); v[i] = *(const f32x4*)(W + (size_t)(k0 + kk) * ldw + sg * 32 + (lane & 7) * 4); }
    } else {
#pragma unroll
        for (int i = 0; i < 8; ++i) v[i] = (f32x4){0.f, 0.f, 0.f, 0.f};
    }
#pragma unroll
    for (int i = 0; i < 8; ++i) { const int kk = i * 8 + (lane >> 3); LAS float* p = scr + kk * 33 + (lane & 7) * 4; p[0] = v[i][0]; p[1] = v[i][1]; p[2] = v[i][2]; p[3] = v[i][3]; }
    LDS_WAIT();
    const int c = lane & 7;
#pragma unroll
    for (int j = 0; j < 4; ++j) { const int n = (lane >> 3) + 8 * j; const LAS float* s = scr + (8 * c) * 33 + n;
        u32x4 o; o.x = pk2(s[0 * 33], s[1 * 33]); o.y = pk2(s[2 * 33], s[3 * 33]); o.z = pk2(s[4 * 33], s[5 * 33]); o.w = pk2(s[6 * 33], s[7 * 33]);
        *(u32x4*)(dst + (size_t)(g * 32 + n) * K + k0 + 8 * c) = o; }
    LDS_WAIT();
}

__device__ __forceinline__ void cvt_item8(const float* W, int ldw, int sg, int kb, unsigned char* dst, int K, int g, LAS float* scr, int lane) {
    const int k0 = kb * 64;
    f32x4 v[8];
#pragma unroll
    for (int i = 0; i < 8; ++i) { const int kk = i * 8 + (lane >> 3); v[i] = (sg >= 0) ? *(const f32x4*)(W + (size_t)(k0 + kk) * ldw + sg * 32 + (lane & 7) * 4) : (f32x4){0.f, 0.f, 0.f, 0.f}; }
#pragma unroll
    for (int i = 0; i < 8; ++i) { const int kk = i * 8 + (lane >> 3); LAS float* p = scr + kk * 33 + (lane & 7) * 4; p[0] = v[i][0] * W8_SCALE; p[1] = v[i][1] * W8_SCALE; p[2] = v[i][2] * W8_SCALE; p[3] = v[i][3] * W8_SCALE; }
    LDS_WAIT();
    const int c = lane & 3;
#pragma unroll
    for (int j = 0; j < 2; ++j) { const int n = (lane >> 2) + 16 * j; const LAS float* s = scr + (16 * c) * 33 + n;
        u32x4 o; o.x = pk4_fp8(s[0 * 33], s[1 * 33], s[2 * 33], s[3 * 33]); o.y = pk4_fp8(s[4 * 33], s[5 * 33], s[6 * 33], s[7 * 33]);
        o.z = pk4_fp8(s[8 * 33], s[9 * 33], s[10 * 33], s[11 * 33]); o.w = pk4_fp8(s[12 * 33], s[13 * 33], s[14 * 33], s[15 * 33]);
        *(u32x4*)(dst + (size_t)(g * 32 + n) * K + k0 + 16 * c) = o; }
    LDS_WAIT();
}

constexpr int IT_WIN = 184 * 8, IT_UQ = 24 * 2, IT_UKV = 32 * 2, IT_WO = 32 * 4, IT_WOUT = 32 * 8, IT_GU = 64 * 8, IT_DN = 32 * 8;
constexpr int IT_SMALL = IT_WIN + IT_UQ + IT_UKV + 3 * IT_WO + IT_WOUT;
constexpr int IT_LAYER = IT_SMALL + 32 * (IT_GU + IT_DN);
constexpr int IT_CVT = NL * IT_LAYER;
constexpr int IT_MOD = NL * 768, IT_ROPE = 128, IT_MISC = 1;
constexpr int IT_TOTAL = IT_MOD + IT_ROPE + IT_MISC + IT_CVT;

struct CvtDesc { const float* W; int ldw, sg, kb; unsigned char* dst; int K, g, bf; };
__device__ __forceinline__ CvtDesc cvt_desc(Frame& F, int rr) {
    const int l = rr / IT_LAYER; int r = rr - l * IT_LAYER; CvtDesc d; d.bf = 0;
    if (r < IT_WIN) { d.kb = r / 184; d.g = r % 184; d.W = inp(I_WIN) + (size_t)l * 1024 * NIN; d.ldw = NIN; d.sg = d.g < 181 ? d.g : -1; d.dst = (unsigned char*)(F.ws + WS_WIN) + (size_t)l * NINP * 1024; d.K = 1024; return d; } r -= IT_WIN;
    if (r < IT_UQ) { d.kb = r / 24; d.g = r % 24; d.W = inp(I_WUQ) + (size_t)l * 256 * 768; d.ldw = 768; d.sg = d.g; d.dst = (unsigned char*)(F.ws + WS_WUQ) + (size_t)l * 768 * 256; d.K = 256; return d; } r -= IT_UQ;
    if (r < IT_UKV) { d.kb = r / 32; d.g = r % 32; d.W = inp(I_WUKV) + (size_t)l * 128 * 1024; d.ldw = 1024; d.sg = (d.kb < 1) ? d.g : -1; d.dst = (unsigned char*)(F.ws + WS_WUKV) + (size_t)l * 1024 * 256; d.K = 256; return d; } r -= IT_UKV;
    if (r < 3 * IT_WO) { const int br = r / IT_WO, q = r % IT_WO; d.kb = q / 32; d.g = q % 32; d.W = inp(I_WOA + br) + (size_t)l * 512 * 1024; d.ldw = 1024; d.sg = d.g; d.dst = (unsigned char*)(F.ws + WS_WO) + ((size_t)l * 3 + br) * 1024 * 512; d.K = 512; return d; } r -= 3 * IT_WO;
    if (r < IT_WOUT) { d.kb = r / 32; d.g = r % 32; d.W = inp(I_WOUT) + (size_t)l * 1024 * 1024; d.ldw = 1024; d.sg = d.g; d.dst = (unsigned char*)((bf16*)(F.ws + WS_WOUT) + (size_t)l * 1024 * 1024); d.K = 1024; d.bf = 1; return d; } r -= IT_WOUT;
    const int e = r / (IT_GU + IT_DN); r -= e * (IT_GU + IT_DN);
    if (r < IT_GU) { d.kb = r / 64; d.sg = r % 64; d.g = (d.sg < 32) ? (8 * (d.sg >> 2) + (d.sg & 3)) : (8 * ((d.sg - 32) >> 2) + 4 + (d.sg & 3));
        d.W = inp(I_WGU) + ((size_t)l * 32 + e) * 1024 * 2048; d.ldw = 2048; d.dst = (unsigned char*)(F.ws + WS_WGU) + ((size_t)l * 32 + e) * 2048 * 1024; d.K = 1024; return d; } r -= IT_GU;
    d.kb = r / 32; d.g = r % 32; d.sg = d.g; d.W = inp(I_WDN) + ((size_t)l * 32 + e) * 1024 * 1024; d.ldw = 1024; d.dst = (unsigned char*)(F.ws + WS_WDN) + ((size_t)l * 32 + e) * 1024 * 1024; d.K = 1024; return d;
}
__device__ __forceinline__ void cvt_load(const CvtDesc& d, int lane, f32x4 (&v)[16]) {
    const int k0 = d.kb * 128;
#pragma unroll
    for (int i = 0; i < 16; ++i) { const int kk = i * 8 + (lane >> 3);
        v[i] = (d.sg >= 0) ? __builtin_nontemporal_load((const f32x4*)(d.W + (size_t)(k0 + kk) * d.ldw + d.sg * 32 + (lane & 7) * 4)) : (f32x4){0.f, 0.f, 0.f, 0.f}; }
}
__device__ __forceinline__ void cvt_finish(const CvtDesc& d, const f32x4 (&v)[16], LAS float* scr, int lane) {
    const int k0 = d.kb * 128; const float sc = d.bf ? 1.0f : W8_SCALE;
#pragma unroll
    for (int h = 0; h < 2; ++h) {
        if (((lane >> 2) & 1) == h) {
#pragma unroll
            for (int i = 0; i < 16; ++i) { const int kk = i * 8 + (lane >> 3); LAS float* p = scr + kk * 17 + (lane & 3) * 4; p[0] = v[i][0] * sc; p[1] = v[i][1] * sc; p[2] = v[i][2] * sc; p[3] = v[i][3] * sc; } }
        LDS_WAIT();
        if (d.bf) { const int c = lane & 15; bf16* dst = (bf16*)d.dst;
#pragma unroll
            for (int j = 0; j < 4; ++j) { const int n = (lane >> 4) + 4 * j; const LAS float* s = scr + (8 * c) * 17 + n;
                u32x4 o; o.x = pk2(s[0 * 17], s[1 * 17]); o.y = pk2(s[2 * 17], s[3 * 17]); o.z = pk2(s[4 * 17], s[5 * 17]); o.w = pk2(s[6 * 17], s[7 * 17]);
                *(u32x4*)(dst + (size_t)(d.g * 32 + 16 * h + n) * d.K + k0 + 8 * c) = o; } }
        else { const int c = lane & 7;
#pragma unroll
            for (int j = 0; j < 2; ++j) { const int n = (lane >> 3) + 8 * j; const LAS float* s = scr + (16 * c) * 17 + n;
                u32x4 o; o.x = pk4_fp8(s[0 * 17], s[1 * 17], s[2 * 17], s[3 * 17]); o.y = pk4_fp8(s[4 * 17], s[5 * 17], s[6 * 17], s[7 * 17]);
                o.z = pk4_fp8(s[8 * 17], s[9 * 17], s[10 * 17], s[11 * 17]); o.w = pk4_fp8(s[12 * 17], s[13 * 17], s[14 * 17], s[15 * 17]);
                *(u32x4*)(d.dst + (size_t)(d.g * 32 + 16 * h + n) * d.K + k0 + 16 * c) = o; } }
        LDS_WAIT();
    }
}
__device__ __forceinline__ void p0_prologue(Frame& F) {
    LAS float* sil = (LAS float*)(F.lds + 73728);
    for (int i = F.tid; i < 3 * 1024; i += NTHREADS) { const int s = i >> 10, k = i & 1023; const float cv = (s < 2) ? inp(I_C)[s * 1024 + k] : inp(I_CCTX)[k]; sil[i] = cv * sigmoidf_(cv); }
    __syncthreads();
    LAS float* scr = (LAS float*)(F.lds + F.wave * 8704);
    const int gw = F.vcu * NWAVES + F.wave, NGW = F.G * NWAVES; const int lane = F.lane;
    float* MOD = (float*)(F.ws + WS_MOD); float* MISC = (float*)(F.ws + WS_MISC);
    for (int it = gw; it < IT_MOD + IT_ROPE + IT_MISC; it += NGW) {
        int r = it;
        if (r < IT_MOD) {
            const int l = r / 768, ch = r % 768, kq = lane >> 3, col = ch * 8 + (lane & 7);
            const float* W = inp(I_WMOD) + (size_t)l * 1024 * 6144 + col;
            float a0 = 0.f, a1 = 0.f, a2 = 0.f;
#pragma unroll 16
            for (int i = 0; i < 128; ++i) { const int k = kq * 128 + i; const float w = W[(size_t)k * 6144]; a0 += sil[k] * w; a1 += sil[1024 + k] * w; a2 += sil[2048 + k] * w; }
#pragma unroll
            for (int o = 8; o < 64; o <<= 1) { a0 += shflx(a0, o); a1 += shflx(a1, o); a2 += shflx(a2, o); }
            if (kq == 0) { const float bb = inp(I_BMOD)[l * 6144 + col]; MOD[(l * 3 + 0) * 6144 + col] = a0 + bb; MOD[(l * 3 + 1) * 6144 + col] = a1 + bb; MOD[(l * 3 + 2) * 6144 + col] = a2 + bb; }
            continue; }
        r -= IT_MOD;
        if (r < IT_ROPE) {
            const int pos = r * 64 + lane; const float prow = (float)(pos / 64), pcol = (float)(pos % 64);
            float* c64 = (float*)(F.ws + WS_ROPE64); float* s64 = c64 + 8192 * 32; float* c32 = (float*)(F.ws + WS_ROPE32); float* s32 = c32 + 8192 * 16;
            for (int i = 0; i < 16; ++i) { const float invf = (float)exp2(-(double)i / 16.0 * 13.287712379549449); float s, c;
                sincos_acc(prow * invf, s, c); c64[pos * 32 + i] = c; s64[pos * 32 + i] = s;
                sincos_acc(pcol * invf, s, c); c64[pos * 32 + 16 + i] = c; s64[pos * 32 + 16 + i] = s; }
            for (int i = 0; i < 8; ++i) { const float invf = (float)exp2(-(double)i / 8.0 * 13.287712379549449); float s, c;
                sincos_acc(prow * invf, s, c); c32[pos * 16 + i] = c; s32[pos * 16 + i] = s;
                sincos_acc(pcol * invf, s, c); c32[pos * 16 + 8 + i] = c; s32[pos * 16 + 8 + i] = s; }
            continue; }
        r -= IT_ROPE;
        if (r < IT_MISC) {
            for (int l = 0; l < NL; ++l) {
                const float* cl = inp(I_CLAM) + l * 128;
                const float p1 = (lane < 32) ? cl[lane] * cl[32 + lane] : 0.f, p2 = (lane < 32) ? cl[64 + lane] * cl[96 + lane] : 0.f;
                const float s1 = wave_sum(p1), s2 = wave_sum(p2);
                const float lam_init = 0.8f - 0.6f * expf(-0.3f * (float)l);
                const float gaq = wave_max(fabsf(inp(I_AQN)[l * 64 + lane])), gak = wave_max(fabsf(inp(I_AKN)[l * 64 + lane]));
                const float gbqn = wave_max(fabsf(inp(I_BQN)[l * 96 + lane])), gbqr = wave_max(lane < 32 ? fabsf(inp(I_BQN)[l * 96 + 64 + lane]) : 0.f);
                const float gbkn = wave_max(fabsf(inp(I_BKN)[l * 96 + lane])), gbkr = wave_max(lane < 32 ? fabsf(inp(I_BKN)[l * 96 + 64 + lane]) : 0.f);
                const float gcq = wave_max(lane < 32 ? fabsf(inp(I_CQN)[l * 32 + lane]) : 0.f), gck = wave_max(lane < 32 ? fabsf(inp(I_CKN)[l * 32 + lane]) : 0.f);
                if (lane == 0) { MISC[l * 8 + 0] = expf(s1) - expf(s2) + lam_init; MISC[l * 8 + 1] = 1.0f - lam_init;
                    MISC[l * 8 + 2] = 8.0f * gaq * gak * LOG2E; MISC[l * 8 + 3] = (64.0f * gbqn * gbkn + 32.0f * gbqr * gbkr) * 0.10206207261596577f * LOG2E;
                    MISC[l * 8 + 4] = 5.656854249492381f * gcq * gck * LOG2E; }
            }
            continue; }
        r -= IT_MISC;
        break;
    }
    { int r = gw; if (r < IT_CVT) { CvtDesc dc = cvt_desc(F, r); f32x4 vc[16]; cvt_load(dc, lane, vc);
        for (;;) { const int rn = r + NGW; const bool more = rn < IT_CVT; CvtDesc dn = dc; f32x4 vn[16];
            if (more) { dn = cvt_desc(F, rn); cvt_load(dn, lane, vn); }
            cvt_finish(dc, vc, scr, lane);
            if (!more) break;
            dc = dn; r = rn;
#pragma unroll
            for (int i = 0; i < 16; ++i) vc[i] = vn[i]; } } }
}

template <bool FINAL>
__device__ __forceinline__ void p_norm1(Frame& F, int l) {
    const int gw = F.vcu * NWAVES + F.wave, NGW = F.G * NWAVES, lane = F.lane;
    float* X = (float*)(F.ws + WS_X); unsigned char* H8 = (unsigned char*)(F.ws + WS_H8); const bf16* OUTA = (const bf16*)(F.ws + WS_OUTA); const float* MOD = (const float*)(F.ws + WS_MOD);
    const bool first = (!FINAL && l == 0);
    for (int row0 = gw; row0 < T; row0 += 2 * NGW) {
        f32x4 v[2][4]; u32x2 oa[2][4][4];
#pragma unroll
        for (int q = 0; q < 2; ++q) { const int row = row0 + q * NGW; if (row >= T) continue;
            const int b = row / TB, rr = row - b * TB; const bool isctx = rr < CTX;
            if (FINAL && isctx) continue;
            if (first) { const float* src = isctx ? inp(I_CTX) + (size_t)(b * CTX + rr) * D : inp(I_X) + (size_t)(b * SEQ + rr - CTX) * D;
#pragma unroll
                for (int j = 0; j < 4; ++j) v[q][j] = *(const f32x4*)(src + 4 * lane + 256 * j);
            } else {
#pragma unroll
                for (int j = 0; j < 4; ++j) { const int col = 4 * lane + 256 * j; v[q][j] = *(const f32x4*)(X + (size_t)row * D + col);
#pragma unroll
                    for (int k = 0; k < 4; ++k) oa[q][j][k] = *(const u32x2*)(OUTA + ((size_t)row * 4 + k) * D + col); } } }
#pragma unroll
        for (int q = 0; q < 2; ++q) { const int row = row0 + q * NGW; if (row >= T) continue;
            const int b = row / TB, rr = row - b * TB; const bool isctx = rr < CTX; const int set = isctx ? 2 : b;
            if (FINAL && isctx) continue;
            if (!first) { const float* g2 = MOD + ((size_t)((FINAL ? NL - 1 : l - 1) * 3 + set)) * 6144 + 5 * 1024;
#pragma unroll
                for (int j = 0; j < 4; ++j) { const int col = 4 * lane + 256 * j; f32x4 s = (f32x4){0.f, 0.f, 0.f, 0.f};
#pragma unroll
                    for (int k = 0; k < 4; ++k) { const u32x2 w = oa[q][j][k]; s += (f32x4){bflo(w.x), bfhi(w.x), bflo(w.y), bfhi(w.y)}; }
                    v[q][j] += *(const f32x4*)(g2 + col) * s; } }
            if (FINAL) { float* o = outp() + (size_t)(b * SEQ + rr - CTX) * D;
#pragma unroll
                for (int j = 0; j < 4; ++j) *(f32x4*)(o + 4 * lane + 256 * j) = v[q][j];
                continue; }
            float ss = 0.f;
#pragma unroll
            for (int j = 0; j < 4; ++j) { *(f32x4*)(X + (size_t)row * D + 4 * lane + 256 * j) = v[q][j]; ss += (v[q][j].x * v[q][j].x + v[q][j].y * v[q][j].y) + (v[q][j].z * v[q][j].z + v[q][j].w * v[q][j].w); }
            const float rstd = rsqrtf(wave_sum(ss) * (1.0f / D) + NORM_EPS);
            const float* gain = inp(I_NMIX) + l * D; const float* sh = MOD + ((size_t)(l * 3 + set)) * 6144; const float* sc = sh + 1024;
#pragma unroll
            for (int j = 0; j < 4; ++j) { const int col = 4 * lane + 256 * j; const f32x4 gn = *(const f32x4*)(gain + col), s1 = *(const f32x4*)(sc + col), h1 = *(const f32x4*)(sh + col);
                const f32x4 y = v[q][j] * rstd * gn * (1.0f + s1) + h1;
                *(unsigned*)(H8 + (size_t)row * D + col) = pk4_fp8(y.x, y.y, y.z, y.w); } }
    }
}

struct PieceDesc { int gwl; const float* gain; int rope; int dbase; float scale; bool active; };
template <int RM>
__device__ __forceinline__ void piece_norm(const u32x4 raw, const PieceDesc& pd, int lane, bool lat, int pos, const float* c64, const float* c32, float (&out)[8]) {
    const int half = pd.rope >> 1;
    const bool dorope = lat && pd.rope != 0 && pd.active;
    const bool first = pd.dbase < half;
    const float* gp_ = pd.active ? pd.gain : c32;
    const int p_ = first ? pd.dbase : pd.dbase - half; const float* ct = (RM == 64) ? c64 + (size_t)pos * 32 + p_ : c32 + (size_t)pos * 16 + p_; const float* st = ct + ((RM == 64) ? 8192 * 32 : 8192 * 16);
    const f32x4 gl0 = *(const f32x4*)gp_, gl1 = *(const f32x4*)(gp_ + 4);
    const f32x4 cl0 = *(const f32x4*)ct, cl1 = *(const f32x4*)(ct + 4), sl0 = *(const f32x4*)st, sl1 = *(const f32x4*)(st + 4);
    float v[8] = {bflo(raw.x), bfhi(raw.x), bflo(raw.y), bfhi(raw.y), bflo(raw.z), bfhi(raw.z), bflo(raw.w), bfhi(raw.w)};
    float ss = 0.f;
#pragma unroll
    for (int j = 0; j < 8; ++j) ss += v[j] * v[j];
    ss += dppf<DPP_X1>(ss); ss += dppf<DPP_X2>(ss);
    { const float t = dppf<DPP_HM>(ss); ss += (pd.gwl > 4) ? t : 0.f; }
    { const float t = dppf<DPP_RM>(ss); ss += (pd.gwl > 8) ? t : 0.f; }
    { const float t = shflx(ss, 16); ss += (pd.gwl > 16) ? t : 0.f; }
    const float rstd = rsqrtf(ss / (float)(pd.gwl * 8) + NORM_EPS);
    const f32x4 one4 = (f32x4){1.f, 1.f, 1.f, 1.f}, zero4 = (f32x4){0.f, 0.f, 0.f, 0.f};
    const f32x4 g0 = pd.active ? gl0 : one4, g1 = pd.active ? gl1 : one4;
    float y[8];
#pragma unroll
    for (int j = 0; j < 4; ++j) { y[j] = v[j] * rstd * g0[j]; y[4 + j] = v[4 + j] * rstd * g1[j]; }
    const f32x4 cs0 = dorope ? cl0 : one4, cs1 = dorope ? cl1 : one4, sn0 = dorope ? sl0 : zero4, sn1 = dorope ? sl1 : zero4;
#pragma unroll
    for (int j = 0; j < 8; ++j) { float yp;
        if constexpr (RM == 32) yp = dppf<DPP_X2>(y[j]);
        else { const float pu = dppf<0x104>(y[j])  , pd4 = dppf<0x114>(y[j])  ; yp = (lane & 4) ? pd4 : pu; } const float c = (j < 4) ? cs0[j & 3] : cs1[j & 3], s = (j < 4) ? sn0[j & 3] : sn1[j & 3];
        out[j] = (y[j] * c + (first ? -yp : yp) * s) * pd.scale; }
}
__device__ __forceinline__ u32x4 pack8(const float (&o)[8]) { u32x4 w; w.x = pk2(o[0], o[1]); w.y = pk2(o[2], o[3]); w.z = pk2(o[4], o[5]); w.w = pk2(o[6], o[7]); return w; }

__host__ __device__ __forceinline__ int vt_perm(int kv) { const int top = kv >> 5, w = kv & 31; return 32 * ((w >> 2) & 1) + 16 * top + 4 * (w >> 3) + (w & 3); }
__device__ __forceinline__ void vt8_block(const bf16* src, int sp, unsigned char* dst, LAS unsigned char* scr, int lane) {
    const bf16* rp = src + (size_t)lane * sp; const int p = vt_perm(lane);
    u32x4 r[8];
#pragma unroll
    for (int i = 0; i < 8; ++i) r[i] = *(const u32x4*)(rp + i * 8);
#pragma unroll
    for (int i = 0; i < 8; ++i) {
        const unsigned a = pk4_fp8(bflo(r[i].x), bfhi(r[i].x), bflo(r[i].y), bfhi(r[i].y)), b = pk4_fp8(bflo(r[i].z), bfhi(r[i].z), bflo(r[i].w), bfhi(r[i].w));
#pragma unroll
        for (int j = 0; j < 4; ++j) { scr[(8 * i + j) * 64 + p] = (unsigned char)(a >> (8 * j)); scr[(8 * i + 4 + j) * 64 + p] = (unsigned char)(b >> (8 * j)); } }
    LDS_WAIT();
    unsigned char* dp = dst + (size_t)lane * TB;
#pragma unroll
    for (int i = 0; i < 4; ++i) *(u32x4*)(dp + 16 * i) = *(const LAS u32x4*)(scr + lane * 64 + 16 * i);
    LDS_WAIT();
}
__device__ __forceinline__ void p_post1(Frame& F, int l) {
    const int gw = F.vcu * NWAVES + F.wave, NGW = F.G * NWAVES, lane = F.lane;
    const bf16* RAW = (const bf16*)(F.ws + WS_RAW);
    unsigned char* Q8a = (unsigned char*)(F.ws + WS_Q8A); unsigned char* K8a = (unsigned char*)(F.ws + WS_K8A); unsigned char* K8b = (unsigned char*)(F.ws + WS_K8B);
    unsigned char* CQN8 = (unsigned char*)(F.ws + WS_CQN); unsigned char* Q8c = (unsigned char*)(F.ws + WS_Q8C); unsigned char* K8c = (unsigned char*)(F.ws + WS_K8C);
    const float* c64 = (const float*)(F.ws + WS_ROPE64); const float* c32 = (const float*)(F.ws + WS_ROPE32);
    const float qsA = 4.0f * 0.125f * LOG2E, qsC = 8.0f * 0.17677669529663687f * LOG2E;
    for (int row0 = gw; row0 < T; row0 += 2 * NGW) {
        u32x4 raw2[2][3];
        const int cq_ = lane >> 5, cv_ = lane & 31, crow_ = row0 + cq_ * NGW; const bool cisk = cv_ >= 16;
#pragma unroll
        for (int q = 0; q < 2; ++q) { const int row = row0 + q * NGW; if (row < T) {
#pragma unroll
            for (int p = 0; p < 3; ++p) raw2[q][p] = *(const u32x4*)(RAW + (size_t)row * NINP + 512 * p + 8 * lane); } }
#pragma unroll
        for (int q = 0; q < 2; ++q) { const int row = row0 + q * NGW; if (row >= T) continue;
        const int b = row / TB, rr = row - b * TB; const bool lat = rr >= CTX; const int pos = lat ? rr - CTX : 0;
        u32x4 raw[3];
#pragma unroll
        for (int p = 0; p < 3; ++p) raw[p] = raw2[q][p];
        if (lane < 16) { unsigned zz = 0u; asm volatile("" : "+v"(zz)); *(u32x2*)(CQN8 + (size_t)row * 512 + 384 + lane * 8) = (u32x2){zz, zz}; }
#pragma unroll
        for (int p = 0; p < 3; ++p) {
            const int col = 512 * p + 8 * lane;
            PieceDesc pd; pd.gwl = 4; pd.gain = nullptr; pd.rope = 0; pd.dbase = 0; pd.scale = 1.f; pd.active = false;
            bf16* dst = nullptr; unsigned char* dst8 = nullptr; int kind = 0;
            if (col < CA_K) { pd.gwl = 8; pd.gain = inp(I_AQN) + l * 64 + (col & 63); pd.rope = 64; pd.dbase = col & 63; pd.scale = qsA; pd.active = true; dst8 = Q8a + (size_t)row * 256 + (col >> 1); kind = 4; }
            else if (col < CA_V) { const int c2 = col - CA_K; pd.gwl = 8; pd.gain = inp(I_AKN) + l * 64 + (c2 & 63); pd.rope = 64; pd.dbase = c2 & 63; pd.active = true; dst8 = K8a + (size_t)row * 64 + (c2 >> 1); kind = 4; }
            else if (col < CB_CQ) { }
            else if (col < CB_CKV) { const int c2 = col - CB_CQ; pd.gwl = 32; pd.gain = inp(I_BQAN) + l * 256 + c2; pd.active = true; dst8 = CQN8 + (size_t)row * 512 + c2; kind = 3; }
            else if (col < CB_KR) { const int c2 = col - CB_CKV; pd.gwl = 16; pd.gain = inp(I_BKVAN) + l * 128 + c2; pd.active = true; dst8 = CQN8 + (size_t)row * 512 + 256 + c2; kind = 3; }
            else if (col < CC_Q) { const int c2 = col - CB_KR; pd.gwl = 4; pd.gain = inp(I_BKN) + l * 96 + 64 + c2; pd.rope = 32; pd.dbase = c2; pd.active = true; dst8 = K8b + (size_t)row * 512 + 32 + (c2 >> 1); kind = 5; }
            float o[8]; if (p < 2) piece_norm<64>(raw[p], pd, lane, lat, pos, c64, c32, o); else piece_norm<32>(raw[p], pd, lane, lat, pos, c64, c32, o);
            if (kind == 1) *(u32x4*)dst = pack8(o);
            else if (kind == 4) *(unsigned*)dst8 = pk8_fp4x2(o);
            else if (kind == 5) { const unsigned w4 = pk8_fp4x2(o);
#pragma unroll
                for (int h = 0; h < 8; ++h) *(unsigned*)(dst8 + h * 64) = w4; }
            else if (kind != 0) { u32x2 w8; w8.x = pk4_fp8(o[0], o[1], o[2], o[3]); w8.y = pk4_fp8(o[4], o[5], o[6], o[7]);
                if (kind == 3) *(u32x2*)dst8 = w8;
                else {
#pragma unroll
                    for (int h = 0; h < 8; ++h) *(u32x2*)(dst8 + h * 128) = w8; } }
        }
    }
        if (crow_ < T) {
            const int b = crow_ / TB, rr = crow_ - b * TB; const bool lat = rr >= CTX; const int pos = lat ? rr - CTX : 0;
            u32x4 rc[4];
            { const bf16* src = RAW + (size_t)crow_ * NINP + (cisk ? CC_K : CC_Q) + (cv_ & 15) * 32;
#pragma unroll
              for (int i = 0; i < 4; ++i) rc[i] = *(const u32x4*)(src + 8 * i); }
            float x[32];
#pragma unroll
            for (int i = 0; i < 4; ++i) { x[8 * i] = bflo(rc[i].x); x[8 * i + 1] = bfhi(rc[i].x); x[8 * i + 2] = bflo(rc[i].y); x[8 * i + 3] = bfhi(rc[i].y); x[8 * i + 4] = bflo(rc[i].z); x[8 * i + 5] = bfhi(rc[i].z); x[8 * i + 6] = bflo(rc[i].w); x[8 * i + 7] = bfhi(rc[i].w); }
            float ss = 0.f;
#pragma unroll
            for (int j = 0; j < 32; ++j) ss += x[j] * x[j];
            const float rstd = rsqrtf(ss * (1.0f / 32.0f) + NORM_EPS) * (cisk ? 1.0f : qsC);
            const float* gp = (cisk ? inp(I_CKN) : inp(I_CQN)) + l * 32;
#pragma unroll
            for (int i = 0; i < 8; ++i) { const f32x4 g = *(const f32x4*)(gp + 4 * i);
#pragma unroll
                for (int j = 0; j < 4; ++j) x[4 * i + j] *= rstd * g[j]; }
            if (lat) { const float* ct = c32 + (size_t)pos * 16; const float* st = ct + 8192 * 16;
#pragma unroll
                for (int i = 0; i < 4; ++i) { const f32x4 c = *(const f32x4*)(ct + 4 * i), sn = *(const f32x4*)(st + 4 * i);
#pragma unroll
                    for (int j = 0; j < 4; ++j) { const float x1 = x[4 * i + j], x2 = x[16 + 4 * i + j]; x[4 * i + j] = x1 * c[j] - x2 * sn[j]; x[16 + 4 * i + j] = x2 * c[j] + x1 * sn[j]; } } }
            v16f_t va, vb;
#pragma unroll
            for (int j = 0; j < 16; ++j) { va[j] = x[j]; vb[j] = x[16 + j]; }
            const v6u_t w6 = __builtin_amdgcn_cvt_scalef32_2xpk16_fp6_f32(va, vb, cisk ? 0.5f : 1.0f);
            unsigned char* dst = (cisk ? K8c : Q8c) + (size_t)crow_ * 512 + (cv_ & 15) * 32;
            *(u32x4*)dst = (u32x4){w6[0], w6[1], w6[2], w6[3]}; *(u32x2*)(dst + 16) = (u32x2){w6[4], w6[5]};
        }
    }
    { LAS unsigned char* scr = F.lds + F.wave * 4096; unsigned char* Vt = (unsigned char*)(F.ws + WS_VT8A);
      for (int blk = gw; blk < NB * 2 * 132; blk += NGW) { const int t = blk % 132, bg = blk / 132;
          vt8_block(RAW + ((size_t)(bg >> 1) * TB + (size_t)t * 64) * NINP + CA_V + (bg & 1) * 64, NINP, Vt + (size_t)bg * 64 * TB + (size_t)t * 64, scr, lane); }
      unsigned char* Vc = (unsigned char*)(F.ws + WS_VT8C);
      for (int blk = gw; blk < NB * 8 * 132; blk += NGW) { const int t = blk % 132, bh = blk / 132;
          vt8_block(RAW + ((size_t)(bh >> 3) * TB + (size_t)t * 64) * NINP + CC_V + (bh & 7) * 64, NINP, Vc + (size_t)bh * 64 * TB + (size_t)t * 64, scr, lane); } }
}
__device__ __forceinline__ void p_post2(Frame& F, int l) {
    const int gw = F.vcu * NWAVES + F.wave, NGW = F.G * NWAVES, lane = F.lane;
    const bf16* RAW2 = (const bf16*)(F.ws + WS_RAW2); unsigned char* Q8b = (unsigned char*)(F.ws + WS_Q8B); unsigned char* K8b = (unsigned char*)(F.ws + WS_K8B);
    const float* c64 = (const float*)(F.ws + WS_ROPE64); const float* c32 = (const float*)(F.ws + WS_ROPE32);
    const float qsB = 4.0f * 0.10206207261596577f * LOG2E;
    const int h8 = lane >> 3, i8 = lane & 7, h4 = (lane >> 2) & 7, i4 = lane & 3;
    u32x4 n0 = {}, n1 = {}, n2 = {};
#define P2_LOAD(row_) do { if ((row_) < T) { const bf16* rp_ = RAW2 + (size_t)(row_) * 1792; n0 = *(const u32x4*)(rp_ + h8 * 96 + i8 * 8);        \
        n1 = *(const u32x4*)(rp_ + h4 * 96 + 64 + i4 * 8);        n2 = *(const u32x4*)(rp_ + 768 + h8 * 128 + i8 * 8);        } } while (0)
    P2_LOAD(gw);
    for (int row = gw; row < T; row += NGW) {
        const int b = row / TB, rr = row - b * TB; const bool lat = rr >= CTX; const int pos = lat ? rr - CTX : 0;
        const u32x4 r0 = n0, r1 = n1, r2 = n2;
        P2_LOAD(row + NGW);
        float o[8];
        { PieceDesc pd; pd.gwl = 8; pd.gain = inp(I_BQN) + l * 96 + i8 * 8; pd.rope = 0; pd.dbase = 0; pd.scale = qsB; pd.active = true;
          piece_norm<32>(r0, pd, lane, lat, pos, c64, c32, o); *(unsigned*)(Q8b + (size_t)row * 512 + h8 * 64 + i8 * 4) = pk8_fp4x2(o); }
        { PieceDesc pd; pd.gwl = 4; pd.gain = inp(I_BQN) + l * 96 + 64 + i4 * 8; pd.rope = 32; pd.dbase = i4 * 8; pd.scale = qsB; pd.active = true;
          piece_norm<32>(r1, pd, lane, lat, pos, c64, c32, o); const unsigned w4 = pk8_fp4x2(o);
          if (lane < 32) { *(unsigned*)(Q8b + (size_t)row * 512 + h4 * 64 + 32 + i4 * 4) = w4; unsigned zz = 0u; asm volatile("" : "+v"(zz)); *(unsigned*)(Q8b + (size_t)row * 512 + h4 * 64 + 48 + i4 * 4) = zz; *(unsigned*)(K8b + (size_t)row * 512 + h4 * 64 + 48 + i4 * 4) = zz; } }
        { PieceDesc pd; pd.gwl = 8; pd.gain = inp(I_BKN) + l * 96 + i8 * 8; pd.rope = 0; pd.dbase = 0; pd.scale = 1.f; pd.active = true;
          piece_norm<32>(r2, pd, lane, lat, pos, c64, c32, o); *(unsigned*)(K8b + (size_t)row * 512 + h8 * 64 + i8 * 4) = pk8_fp4x2(o); }
    }
#undef P2_LOAD
    { LAS unsigned char* scr = F.lds + F.wave * 4096; unsigned char* Vt = (unsigned char*)(F.ws + WS_VT8B);
      for (int blk = gw; blk < NB * 8 * 132; blk += NGW) { const int t = blk % 132, bh = blk / 132;
          vt8_block(RAW2 + ((size_t)(bh >> 3) * TB + (size_t)t * 64) * 1792 + 768 + (bh & 7) * 128 + 64, 1792, Vt + (size_t)bh * 64 * TB + (size_t)t * 64, scr, lane); } }
}

__device__ __forceinline__ void p_router(Frame& F, int l) {
    const int lane = F.lane, wave = F.wave, tid = F.tid;
    const float* X = (const float*)(F.ws + WS_X); unsigned char* H8 = (unsigned char*)(F.ws + WS_H8); const float* MOD = (const float*)(F.ws + WS_MOD);
    gu32* cnt = (gu32*)(F.ws + WS_CTL) + CW_CNT + l * 32 * 16;
    int* tok = (int*)(F.ws + WS_TOK); float* wl = (float*)(F.ws + WS_WL);
    constexpr int HP = 17;
    LAS float* hT = (LAS float*)(F.lds);
    LAS float* part = (LAS float*)(F.lds + 73728);
    LAS unsigned* hist = (LAS unsigned*)(F.lds + LDSCTL_OFF + LC_HIST); LAS unsigned* base = (LAS unsigned*)(F.lds + LDSCTL_OFF + LC_BASE);
    LAS unsigned* rec = (LAS unsigned*)(F.lds + LDSCTL_OFF + LC_REC);
    if (tid < 32) hist[tid] = 0u;
    const float* rw = inp(I_RW) + (size_t)l * 1024 * 32; const float* rb = inp(I_RB) + l * 32;
    const float* gain = inp(I_NFFN) + l * D;
    const int e = lane & 31, kh = lane >> 5; const int n16 = lane & 15, kg = lane >> 4;
    const int rows_per_wg = (T + F.G - 1) / F.G;
    const int wg_row0 = F.vcu * rows_per_wg;
#define RT_VALID(lr_, row_) ((lr_) < rows_per_wg && (row_) < T && !(l == NL - 1 && ((row_) % TB) < CTX))
    f32x4 v[2][4];
#define RT_LOAD(bt_) do { _Pragma("unroll") for (int q = 0; q < 2; ++q) { const int lr_ = (bt_) * 16 + 2 * wave + q, row_ = wg_row0 + lr_; if (RT_VALID(lr_, row_)) { \
        _Pragma("unroll") for (int j = 0; j < 4; ++j) v[q][j] = *(const f32x4*)(X + (size_t)row_ * D + 4 * lane + 256 * j); } } } while (0)
    RT_LOAD(0);
    float rwreg[64];
#pragma unroll
    for (int i = 0; i < 32; ++i) { const float* rp_ = rw + (size_t)(128 * wave + 4 * i + kg) * 32 + n16; rwreg[2 * i] = rp_[0]; rwreg[2 * i + 1] = rp_[16]; }
    __syncthreads();
    for (int bt = 0; bt * 16 < rows_per_wg; ++bt) {
#pragma unroll
        for (int q = 0; q < 2; ++q) { const int rl = 2 * wave + q; const int lr = bt * 16 + rl, row = wg_row0 + lr;
            if (RT_VALID(lr, row)) {
                const int b = row / TB, rr = row - b * TB; const int set = (rr < CTX) ? 2 : b;
                const float* sh = MOD + ((size_t)(l * 3 + set)) * 6144 + 3 * 1024; const float* sc = sh + 1024;
                float ss = 0.f;
#pragma unroll
                for (int j = 0; j < 4; ++j) ss += (v[q][j].x * v[q][j].x + v[q][j].y * v[q][j].y) + (v[q][j].z * v[q][j].z + v[q][j].w * v[q][j].w);
                const float rstd = rsqrtf(wave_sum(ss) * (1.0f / D) + NORM_EPS);
#pragma unroll
                for (int j = 0; j < 4; ++j) { const int col = 4 * lane + 256 * j; const f32x4 gn = *(const f32x4*)(gain + col), s1 = *(const f32x4*)(sc + col), h1 = *(const f32x4*)(sh + col);
                    const f32x4 y = v[q][j] * rstd * gn * (1.0f + s1) + h1;
                    *(unsigned*)(H8 + (size_t)row * D + col) = pk4_fp8(y.x, y.y, y.z, y.w);
                    hT[(col + 0) * HP + rl] = y.x; hT[(col + 1) * HP + rl] = y.y; hT[(col + 2) * HP + rl] = y.z; hT[(col + 3) * HP + rl] = y.w; }
            } else { float z = 0.f; asm volatile("" : "+v"(z));
#pragma unroll
                for (int j = 0; j < 4; ++j) { const int col = 4 * lane + 256 * j; hT[(col + 0) * HP + rl] = z; hT[(col + 1) * HP + rl] = z; hT[(col + 2) * HP + rl] = z; hT[(col + 3) * HP + rl] = z; } } }
        __syncthreads();
        RT_LOAD(bt + 1);
        f32x4 acc0 = f32x4{}, acc1 = f32x4{};
        { const LAS float* ap = hT + (128 * wave + kg) * HP + n16;
#pragma unroll
          for (int i = 0; i < 32; ++i) { const float a_ = ap[4 * i * HP]; acc0 = __builtin_amdgcn_mfma_f32_16x16x4f32(a_, rwreg[2 * i], acc0, 0, 0, 0); acc1 = __builtin_amdgcn_mfma_f32_16x16x4f32(a_, rwreg[2 * i + 1], acc1, 0, 0, 0); } }
#pragma unroll
        for (int j = 0; j < 4; ++j) { part[(wave * 16 + 4 * kg + j) * 32 + n16] = acc0[j]; part[(wave * 16 + 4 * kg + j) * 32 + 16 + n16] = acc1[j]; }
        __syncthreads();
        { const int r = tid >> 5; const int lr = bt * 16 + r; const int row = wg_row0 + lr; const bool valid = RT_VALID(lr, row);
            float vv = rb[e];
#pragma unroll
            for (int p = 0; p < 8; ++p) vv += part[(p * 16 + r) * 32 + e];
            unsigned key; { const unsigned ub = __float_as_uint(vv); key = ((ub & 0x80000000u) ? ~ub : (ub | 0x80000000u)); key = (key & ~31u) | (unsigned)(31 - e); }
            float tv[4]; int ti[4];
#pragma unroll
            for (int j = 0; j < 4; ++j) { unsigned k = key;
                k = max(k, dppu<DPP_X1>(k)); k = max(k, dppu<DPP_X2>(k)); k = max(k, dppu<DPP_HM>(k)); k = max(k, dppu<DPP_RM>(k)); k = max(k, (unsigned)shflx((int)k, 16));
                const int bi = 31 - (int)(k & 31u); const unsigned kb = k & ~31u; const unsigned ub = (kb & 0x80000000u) ? (kb & 0x7FFFFFFFu) : ~kb;
                tv[j] = __uint_as_float(ub); ti[j] = bi; if (e == bi) key = 0u; }
            const float e1 = __expf(tv[1] - tv[0]), e2 = __expf(tv[2] - tv[0]), e3 = __expf(tv[3] - tv[0]); const float inv = 1.0f / (1.0f + e1 + e2 + e3);
            if (valid && e < 4) { const int ee = (e == 0) ? ti[0] : (e == 1) ? ti[1] : (e == 2) ? ti[2] : ti[3]; const float ww = ((e == 0) ? 1.0f : (e == 1) ? e1 : (e == 2) ? e2 : e3) * inv;
                const unsigned rank = __hip_atomic_fetch_add(&hist[ee], 1u, __ATOMIC_RELAXED, __HIP_MEMORY_SCOPE_WORKGROUP);
                LAS unsigned* rp = rec + (lr * 4 + e) * 4; rp[0] = (unsigned)ee; rp[1] = rank; rp[2] = __float_as_uint(ww); rp[3] = (unsigned)(row * 4 + e); }
            else if (e < 4 && lr < rows_per_wg) { rec[(lr * 4 + e) * 4] = 0xFFFFFFFFu; }
        }
    }
#undef RT_VALID
#undef RT_LOAD
    __syncthreads();
    if (tid < 32) { const unsigned n = hist[tid]; base[tid] = n ? __hip_atomic_fetch_add(cnt + tid * 16, n, __ATOMIC_RELAXED, __HIP_MEMORY_SCOPE_AGENT) : 0u; }
    __syncthreads();
    const int nrec = min(rows_per_wg, max(0, T - wg_row0)) * 4;
    for (int i = tid; i < nrec; i += NTHREADS) { const LAS unsigned* rp = rec + i * 4; const unsigned ee = rp[0]; if (ee == 0xFFFFFFFFu) continue; const unsigned slot = base[ee] + rp[1];
        tok[(size_t)ee * CAP + slot] = (int)rp[3]; wl[(size_t)ee * CAP + slot] = __uint_as_float(rp[2]); }
    __syncthreads();
}

__device__ __forceinline__ f32x16 small_tile(const bf16* A, int lda, const bf16* Bt, int ldb, int K, f32x16 acc, int lane) {
    const int r = lane & 31, h = lane >> 5;
    const bf16* ap = A + (size_t)r * lda + 8 * h; const bf16* bp = Bt + (size_t)r * ldb + 8 * h;
    for (int k0 = 0; k0 < K; k0 += 128) { bf16x8 a[8], b[8];
#pragma unroll
        for (int i = 0; i < 8; ++i) { a[i] = *(const bf16x8*)(ap + k0 + 16 * i); b[i] = *(const bf16x8*)(bp + k0 + 16 * i); }
        asm volatile("" ::: "memory");
#pragma unroll
        for (int i = 0; i < 8; ++i) acc = __builtin_amdgcn_mfma_f32_32x32x16_bf16(a[i], b[i], acc, 0, 0, 0); }
    return acc;
}
__device__ __forceinline__ f32x16 small_tile8(const unsigned char* A, int lda, const unsigned char* Bt, int ldb, int K, f32x16 acc, int lane) {
    const int r = lane & 31, h = lane >> 5;
    const unsigned char* ap = A + (size_t)r * lda + 32 * h; const unsigned char* bp = Bt + (size_t)r * ldb + 32 * h;
    for (int k0 = 0; k0 < K; k0 += 128) { v8i_t a[2], b[2];
#pragma unroll
        for (int i = 0; i < 2; ++i) { const int k = k0 + 64 * i; a[i] = __builtin_shufflevector(*(const v4i_t*)(ap + k), *(const v4i_t*)(ap + k + 16), 0, 1, 2, 3, 4, 5, 6, 7);
            b[i] = __builtin_shufflevector(*(const v4i_t*)(bp + k), *(const v4i_t*)(bp + k + 16), 0, 1, 2, 3, 4, 5, 6, 7); }
        asm volatile("" ::: "memory");
#pragma unroll
        for (int i = 0; i < 2; ++i) acc = __builtin_amdgcn_mfma_scale_f32_32x32x64_f8f6f4(a[i], b[i], acc, 0, 0, 0, 0x7F7F7F7F, 0, 0x7F7F7F7F); }
    return acc;
}
__device__ __forceinline__ void ctx_merge_small(Frame& F, int l) {
    const bf16* RAW = (const bf16*)(F.ws + WS_RAW); bf16* Y = (bf16*)(F.ws + WS_Y); const int lane = F.lane, c = lane & 31, hi = lane >> 5;
    const int tt = F.wave >> 2, kq = F.wave & 3;
    LAS float* red = (LAS float*)F.lds;
    for (int base = 0; base < 512; base += 2 * F.G) {
        const int tile = base + tt * F.G + F.vcu; const bool valid = tile < 512;
        const int rb = tile >> 5, cb = tile & 31; const int row0 = (rb >> 3) * TB + (rb & 7) * 32, col0 = cb * 32;
        bf16 gq[3][16];
#pragma unroll
        for (int br = 0; br < 3; ++br)
#pragma unroll
            for (int i = 0; i < 16; ++i) gq[br][i] = 0;
        if (valid && kq == 0) {
#pragma unroll
            for (int br = 0; br < 3; ++br)
#pragma unroll
                for (int i = 0; i < 16; ++i) { const int row = row0 + (i & 3) + 8 * (i >> 2) + 4 * hi; gq[br][i] = RAW[(size_t)row * NINP + CGATE + br * 1024 + col0 + c]; } }
        v8i_t av[3][2], bv[3][2];
        { const int r = lane & 31, h = lane >> 5;
#pragma unroll
          for (int br = 0; br < 3; ++br) {
              const unsigned char* ap = (const unsigned char*)(F.ws + WS_OA + (size_t)br * (WS_OB - WS_OA)) + (size_t)row0 * 512 + kq * 128 + (size_t)r * 512 + 32 * h;
              const unsigned char* bp = (const unsigned char*)(F.ws + WS_WO) + ((size_t)l * 3 + br) * 1024 * 512 + (size_t)col0 * 512 + kq * 128 + (size_t)r * 512 + 32 * h;
#pragma unroll
              for (int i = 0; i < 2; ++i) { av[br][i] = v8i_t{}; bv[br][i] = v8i_t{};
                  if (valid) { av[br][i] = __builtin_shufflevector(*(const v4i_t*)(ap + 64 * i), *(const v4i_t*)(ap + 64 * i + 16), 0, 1, 2, 3, 4, 5, 6, 7);
                               bv[br][i] = __builtin_shufflevector(*(const v4i_t*)(bp + 64 * i), *(const v4i_t*)(bp + 64 * i + 16), 0, 1, 2, 3, 4, 5, 6, 7); } } } }
        asm volatile("" ::: "memory");
#pragma unroll
        for (int br = 0; br < 3; ++br) { f32x16 acc = f32x16{};
#pragma unroll
            for (int i = 0; i < 2; ++i) acc = __builtin_amdgcn_mfma_scale_f32_32x32x64_f8f6f4(av[br][i], bv[br][i], acc, 0, 0, 0, 0x7F7F7F7F, 0, 0x7F7F7F7F);
#pragma unroll
            for (int i = 0; i < 16; ++i) red[((br * 8 + F.wave) * 16 + i) * 64 + lane] = acc[i]; }
        __syncthreads();
        if (valid && kq == 0) {
#pragma unroll
            for (int i = 0; i < 16; ++i) { float y = 0.f;
#pragma unroll
                for (int br = 0; br < 3; ++br) { float sum = 0.f;
#pragma unroll
                    for (int q = 0; q < 4; ++q) sum += red[((br * 8 + tt * 4 + q) * 16 + i) * 64 + lane];
                    y += sigmoidf_(bf2f(gq[br][i])) * W8_INV * sum; }
                const int row = row0 + (i & 3) + 8 * (i >> 2) + 4 * hi; Y[(size_t)row * D + col0 + c] = (bf16)f2bf(y); } }
        __syncthreads();
    }
}
__device__ __forceinline__ void ctx_wout_small(Frame& F, int l) {
    const bf16* Y = (const bf16*)(F.ws + WS_Y); float* X = (float*)(F.ws + WS_X); const int lane = F.lane, c = lane & 31, hi = lane >> 5;
    const float* g1 = (const float*)(F.ws + WS_MOD) + ((size_t)l * 3 + 2) * 6144 + 2 * 1024;
    const int tt = F.wave >> 2, kq = F.wave & 3;
    LAS float* red = (LAS float*)F.lds;
    for (int base = 0; base < 512; base += 2 * F.G) {
        const int tile = base + tt * F.G + F.vcu; const bool valid = tile < 512;
        const int rb = tile >> 5, cb = tile & 31; const int row0 = (rb >> 3) * TB + (rb & 7) * 32, col0 = cb * 32;
        float xold[16]; float g = 0.f;
#pragma unroll
        for (int i = 0; i < 16; ++i) xold[i] = 0.f;
        if (valid && kq == 0) { g = g1[col0 + c];
#pragma unroll
            for (int i = 0; i < 16; ++i) xold[i] = X[(size_t)(row0 + (i & 3) + 8 * (i >> 2) + 4 * hi) * D + col0 + c]; }
        bf16x8 av[16], bv[16];
        { const int r = lane & 31, h = lane >> 5;
          const bf16* ap = Y + (size_t)row0 * D + kq * 256 + (size_t)r * D + 8 * h;
          const bf16* bp = (const bf16*)(F.ws + WS_WOUT) + (size_t)l * 1024 * 1024 + (size_t)col0 * 1024 + kq * 256 + (size_t)r * 1024 + 8 * h;
#pragma unroll
          for (int i = 0; i < 16; ++i) { av[i] = bf16x8{}; bv[i] = bf16x8{}; if (valid) { av[i] = *(const bf16x8*)(ap + 16 * i); bv[i] = *(const bf16x8*)(bp + 16 * i); } } }
        asm volatile("" ::: "memory");
        f32x16 acc = f32x16{};
#pragma unroll
        for (int i = 0; i < 16; ++i) acc = __builtin_amdgcn_mfma_f32_32x32x16_bf16(av[i], bv[i], acc, 0, 0, 0);
#pragma unroll
        for (int i = 0; i < 16; ++i) red[(F.wave * 16 + i) * 64 + lane] = acc[i];
        __syncthreads();
        if (valid && kq == 0) {
#pragma unroll
            for (int i = 0; i < 16; ++i) { float sum = 0.f;
#pragma unroll
                for (int q = 0; q < 4; ++q) sum += red[((tt * 4 + q) * 16 + i) * 64 + lane];
                X[(size_t)(row0 + (i & 3) + 8 * (i >> 2) + 4 * hi) * D + col0 + c] = xold[i] + g * sum; } }
        __syncthreads();
    }
}

constexpr int PH_PER_LAYER = 11, PH_FINAL = 1 + NL * PH_PER_LAYER, N_PHASES = PH_FINAL + 1;

__global__ void __launch_bounds__(NTHREADS, 2) fwd(Args args) {
    extern __shared__ __attribute__((aligned(16))) unsigned char lds_raw[];
    Frame F;
    F.lds = (LAS unsigned char*)lds_raw; F.ws = args.ws;
    F.tid = threadIdx.x; F.lane = F.tid & 63; F.wave = __builtin_amdgcn_readfirstlane(F.tid >> 6);
    F.G = gridDim.x; F.bx = blockIdx.x; { const int bx = blockIdx.x; F.vcu = (F.G % 8 == 0) ? (bx % 8) * (F.G / 8) + bx / 8 : bx; }
    for (int u = F.tid; u < (LDS_BYTES - LDSCTL_OFF) / 4; u += NTHREADS) ((LAS unsigned*)(F.lds + LDSCTL_OFF))[u] = 0u;
    __syncthreads();
    gu32* ctl = (gu32*)(F.ws + WS_CTL);
#if MK_ONE_LAUNCH
    XcdBarrier bar = xcd_barrier_post((unsigned*)ctl + CW_BAR, (volatile LAS unsigned*)(F.lds + LDSCTL_OFF + LC_BAR));
#define GRID_BAR() xcd_barrier(bar)
#else
#define GRID_BAR() do { } while (0)
#endif
    const int lo = args.ph_lo, hi = args.ph_hi; (void)lo; (void)hi;
#ifndef DBG_MASK
#define DBG_MASK 0xFFFFFF
#endif
#if MK_ONE_LAUNCH
#define IN(k) true
#else
#define IN(k) (lo <= (k) && (k) < hi)
#endif
#define EN(j) ((DBG_MASK >> (j)) & 1)
#ifndef DUP_MASK
#define DUP_MASK 0
#endif
#define REP(j) for (int rep_ = 0; rep_ < (((DUP_MASK >> (j)) & 1) ? 2 : 1); ++rep_)
#define SEAM(k) do { if (IN(k) && IN((k) + 1)) GRID_BAR(); } while (0)

#define PH_BEGIN(lv) Frame P; { unsigned long long _w = (unsigned long long)F.ws; unsigned _l = (unsigned)(size_t)F.lds; int _g = F.G, _v = F.vcu, _b = F.bx, _t = threadIdx.x; \
        asm volatile("" : "+s"(_w), "+s"(_l), "+s"(_g), "+s"(_v), "+s"(_b), "+v"(_t)); \
        P.ws = (unsigned char*)(GAS unsigned char*)_w; P.lds = (LAS unsigned char*)_l; P.G = _g; P.vcu = _v; P.bx = _b; P.tid = _t; P.lane = _t & 63; P.wave = __builtin_amdgcn_readfirstlane(_t >> 6); } \
        int pl = (lv); asm volatile("" : "+s"(pl)); \
        const float* MODl = (const float*)(P.ws + WS_MOD) + (size_t)pl * 3 * 6144; const float* MISC = (const float*)(P.ws + WS_MISC) + pl * 8; (void)MODl; (void)MISC;
    if (EN(11) && IN(0)) REP(11) { PH_BEGIN(0); p0_prologue(P); }
    SEAM(0);

    for (int l = 0; l < NL; ++l) {
        const int pb = 1 + l * PH_PER_LAYER;
        if (EN(0) && IN(pb + 0)) { PH_BEGIN(l); p_norm1<false>(P, pl); }
        SEAM(pb + 0);
        if (EN(1) && IN(pb + 1)) REP(1) { PH_BEGIN(l);
            SchedDenseT<true> S{(const char*)(P.ws + WS_H8), (const char*)(P.ws + WS_WIN) + (size_t)pl * NINP * 1024, 1024u, 1024u, 8, 66, 23, P.G, P.bx, 0};
            EpiBf16 E{(bf16*)(P.ws + WS_RAW), NINP, W8_INV};
            gm::gemm_phase(P.lds, S, E);
        }
        SEAM(pb + 1);
        if (EN(2) && IN(pb + 2)) REP(2) { PH_BEGIN(l); p_post1(P, pl); }
        SEAM(pb + 2);
        if (EN(3) && IN(pb + 3)) REP(3) { PH_BEGIN(l);
            SchedUp S{(const char*)(P.ws + WS_CQN), (const char*)(P.ws + WS_WUQ) + (size_t)pl * 768 * 256, (const char*)(P.ws + WS_WUKV) + (size_t)pl * 1024 * 256, P.G, P.bx};
            EpiBf16 E{(bf16*)(P.ws + WS_RAW2), 1792, W8_INV};
            gm::gemm_phase(P.lds, S, E);
        }
        SEAM(pb + 3);
        if (EN(4) && IN(pb + 4)) REP(4) { PH_BEGIN(l); p_post2(P, pl); }
        SEAM(pb + 4);
#define ATT_UNITS(...) do { for (int pass = 0; pass < ((pl == NL - 1) ? 1 : 2); ++pass) { const int nu = pass ? 16 : 512; for (int uu = P.vcu; uu < nu; uu += P.G) { \
                const int bh = pass ? uu : (uu & 255) >> 4; const int qb = pass ? 0 : 1 + 16 * (uu >> 8) + (uu & 15); \
                const int b = bh >> 3, h = bh & 7; const size_t qrow = (size_t)b * TB + (size_t)qb * 256, krow = (size_t)b * TB; const int NT = qb ? 132 : 4; __VA_ARGS__ } } } while (0)
#define ATT_UNITS2(NQB_, ...) do { const int nu = (NQB_ == 2) ? 256 : 16; for (int uu = P.vcu; uu < nu; uu += P.G) { const int bh = (NQB_ == 2) ? uu >> 4 : uu; const int qb = (NQB_ == 2) ? 1 + (uu & 15) : 0; \
                const int b = bh >> 3, h = bh & 7; const size_t qrow = (size_t)b * TB + (size_t)qb * 256, krow = (size_t)b * TB; const int NT = qb ? 132 : 4; __VA_ARGS__ } } while (0)
        if (EN(5) && EN(14) && IN(pb + 5)) REP(14) { PH_BEGIN(l); const float MA = MISC[2];
#define ATT_A(NQB_) ATT_UNITS2(NQB_, { at::Tens8 tn{(const unsigned char*)(P.ws + WS_Q8A) + qrow * 256 + h * 32, 256, (const unsigned char*)(P.ws + WS_K8A) + krow * 64 + (h >> 2) * 32, 64, \
                              (const unsigned char*)(P.ws + WS_VT8A) + (size_t)(b * 2 + (h >> 2)) * 64 * TB, (unsigned char*)(P.ws + WS_OA) + qrow * 512 + h * 64}; \
                  at::attn_unit_x2<32, false, true, NQB_>(P.lds, tn, NT, (4.0f * (8.0f - MA) + 60.5f) * (1.0f / 256.0f), 0.f, nullptr, 0.f, (size_t)16 * 256 * 256, (size_t)16 * 256 * 512); })
            ATT_A(2); if (pl != NL - 1) ATT_A(1);
#undef ATT_A
        }
        if (EN(5) && EN(15) && IN(pb + 5)) REP(15) { PH_BEGIN(l); const float MB = MISC[3];
#define ATT_B(NQB_) ATT_UNITS2(NQB_, { at::Tens8 tn{(const unsigned char*)(P.ws + WS_Q8B) + qrow * 512 + h * 64, 512, (const unsigned char*)(P.ws + WS_K8B) + krow * 512 + h * 64, 512, \
                              (const unsigned char*)(P.ws + WS_VT8B) + (size_t)(b * 8 + h) * 64 * TB, (unsigned char*)(P.ws + WS_OB) + qrow * 512 + h * 64}; \
                  at::attn_unit_x2<64, false, true, NQB_>(P.lds, tn, NT, (4.0f * (8.0f - MB) + 60.5f) * (1.0f / 256.0f), 0.f, nullptr, 0.f, (size_t)16 * 256 * 512, (size_t)16 * 256 * 512); })
            ATT_B(2); if (pl != NL - 1) ATT_B(1);
#undef ATT_B
        }
        if (EN(5) && EN(16) && IN(pb + 5)) REP(16) { PH_BEGIN(l); const float lam = MISC[0], subscale = MISC[1], MC = MISC[4]; const float* subg = inp(I_CSUB) + pl * 64;
            ATT_UNITS({ at::Tens8 tn{(const unsigned char*)(P.ws + WS_Q8C) + qrow * 512 + h * 64, 512, (const unsigned char*)(P.ws + WS_K8C) + krow * 512 + h * 64, 512,
                              (const unsigned char*)(P.ws + WS_VT8C) + (size_t)(b * 8 + h) * 64 * TB, (unsigned char*)(P.ws + WS_OC) + qrow * 512 + h * 64};
                  at::attn_unit_f8d(P.lds, tn, NT, (104.0f - 8.0f * MC - 0.34f + 0.5f) * (1.0f / 256.0f), lam, subg, subscale); }); }
#undef ATT_UNITS
#undef ATT_UNITS2
        SEAM(pb + 5);
        if (EN(6) && IN(pb + 6)) REP(6) { PH_BEGIN(l);
            SchedMerge S{(const char*)(P.ws + WS_OA), (size_t)(WS_OB - WS_OA), (const char*)(P.ws + WS_WO) + (size_t)pl * 3 * 1024 * 512, P.G, P.bx, 1};
            if (pl != NL - 1) ctx_merge_small(P, pl);
            EpiMerge E{(const bf16*)(P.ws + WS_RAW), (bf16*)(P.ws + WS_Y)};
            gm::gemm_phase(P.lds, S, E);
        }
        SEAM(pb + 6);
        if (EN(7) && IN(pb + 7)) { PH_BEGIN(l);
            SchedDense S{(const char*)(P.ws + WS_Y), (const char*)(P.ws + WS_WOUT) + (size_t)pl * 1024 * 1024 * 2, 2048u, 2048u, 16, 64, 4, P.G, P.bx, 1};
            if (pl != NL - 1) ctx_wout_small(P, pl);
            EpiWout E{(float*)(P.ws + WS_X), MODl};
            gm::gemm_phase(P.lds, S, E);
        }
        SEAM(pb + 7);
        if (EN(8) && IN(pb + 8)) { PH_BEGIN(l); p_router(P, pl); }
        SEAM(pb + 8);
#define MOE_PREF_DECL LAS int* pref = (LAS int*)(P.lds + LDSCTL_OFF + LC_PREF); const int* cnt = (const int*)(P.ws + WS_CTL) + CW_CNT + pl * 32 * 16;
#define MOE_PREF_BUILD { LAS int* tl_ = (LAS int*)(P.lds + LDSCTL_OFF + LC_HIST); LAS int* raw_ = (LAS int*)(P.lds + LDSCTL_OFF + LC_CNTRAW); \
            __syncthreads(); \
            if (P.tid < 32) { const int n_ = __hip_atomic_load(cnt + P.tid * 16, __ATOMIC_RELAXED, __HIP_MEMORY_SCOPE_AGENT); raw_[P.tid] = n_; tl_[P.tid] = (n_ + 255) >> 8; } \
            __syncthreads(); \
            if (P.tid < 33) { int s_ = 0; for (int e = 0; e < 32; ++e) s_ += (e < P.tid) ? tl_[e] : 0; pref[P.tid] = s_; } \
            __syncthreads(); \
            if (P.tid < 2 * MOE_MAXU) { const int tb_ = P.tid >> 6, i_ = P.tid & 63, ntn_ = tb_ ? 4 : 8; const long L_ = (long)i_ * P.G + P.bx; const int tot_ = pref[32]; v4i_t d_ = (v4i_t){-1, 0, 0, 0}; \
                if (L_ < (long)tot_ * ntn_) { const int mg_ = (int)(L_ / ntn_), pn_ = (int)(L_ % ntn_); int e_ = 0; for (int k = 1; k < 32; ++k) e_ += (pref[k] <= mg_) ? 1 : 0; \
                    const int mloc_ = mg_ - pref[e_]; const int n_ = raw_[e_]; \
                    d_ = (v4i_t){e_, mg_, (pn_ << 16) | min(256, n_ - mloc_ * 256), e_ * CAP + mloc_ * 256}; } \
                *(LAS v4i_t*)((LAS char*)pref + ((tb_ ? LC_UNIT2 : LC_UNIT) - LC_PREF) + i_ * 16) = d_; } \
            __syncthreads(); }
        if (EN(9) && EN(12) && IN(pb + 9)) REP(12) { PH_BEGIN(l); MOE_PREF_DECL; MOE_PREF_BUILD;
            SchedMoe<true, 8> S{pref, cnt, (const char*)(P.ws + WS_H8), (const char*)(P.ws + WS_WGU) + (size_t)pl * 32 * 2048 * 1024, (const int*)(P.ws + WS_TOK), P.G, P.bx, 1024u, (size_t)2048 * 1024, 8, LC_UNIT - LC_PREF};
            EpiMoe1 E{(unsigned char*)(P.ws + WS_ACT), inp(I_BGU) + (size_t)pl * 32 * 2048};
            gm::gemm_phase(P.lds, S, E);
        }
        SEAM(pb + 9);
        if (EN(9) && EN(10) && IN(pb + 10)) REP(10) { PH_BEGIN(l); MOE_PREF_DECL; if (!MK_ONE_LAUNCH) MOE_PREF_BUILD;
            SchedMoe<false, 4> S{pref, cnt, (const char*)(P.ws + WS_ACT), (const char*)(P.ws + WS_WDN) + (size_t)pl * 32 * 1024 * 1024, (const int*)(P.ws + WS_TOK), P.G, P.bx, 1024u, (size_t)1024 * 1024, 8, LC_UNIT2 - LC_PREF};
            EpiMoe2 E{(bf16*)(P.ws + WS_OUTA), inp(I_BDN) + (size_t)pl * 32 * 1024, (const float*)(P.ws + WS_WL), (const int*)(P.ws + WS_TOK)};
            gm::gemm_phase(P.lds, S, E);
        }
#undef MOE_PREF_DECL
#undef MOE_PREF_BUILD
        SEAM(pb + 10);
    }
    if (EN(13) && IN(PH_FINAL)) { PH_BEGIN(NL); p_norm1<true>(P, pl); }
#undef PH_BEGIN
#undef IN
#undef SEAM
}

extern "C" void kernel_launch(void* const* d_in, const int* in_sizes, int n_in, void* d_out, int out_size, void* d_ws, size_t ws_size, hipStream_t stream) {
    static int grid = 0;
    if (grid == 0) {
        if (n_in != N_INPUTS || ws_size < WS_END) { fprintf(stderr, "kernel_launch: expected %d inputs and >= %zu bytes of workspace, got %d and %zu\n", (int)N_INPUTS, (size_t)WS_END, n_in, ws_size); grid = -1; return; }
        int dev = 0, cus = 0;
        if (hipGetDevice(&dev) != hipSuccess || hipDeviceGetAttribute(&cus, hipDeviceAttributeMultiprocessorCount, dev) != hipSuccess) { grid = -1; return; }
        if (hipFuncSetAttribute((const void*)fwd, hipFuncAttributeMaxDynamicSharedMemorySize, LDS_BYTES) != hipSuccess) { fprintf(stderr, "kernel_launch: hipFuncSetAttribute failed\n"); grid = -1; return; }
        int per_cu = 0;
        if (hipOccupancyMaxActiveBlocksPerMultiprocessor(&per_cu, (const void*)fwd, NTHREADS, LDS_BYTES) != hipSuccess || per_cu < 1) { fprintf(stderr, "kernel_launch: occupancy query reports %d\n", per_cu); }
        (void)hipGetLastError();
        grid = cus;
    }
    if (grid < 0) return;
    (void)hipMemsetAsync((char*)d_ws + WS_CTL, 0, CTL_ZERO_BYTES, stream);
    Args a{};
    for (int i = 0; i < N_INPUTS; ++i) a.in[i] = (const float*)d_in[i];
    a.out = (float*)d_out; a.ws = (unsigned char*)d_ws;
#if MK_ONE_LAUNCH
    a.ph_lo = 0; a.ph_hi = N_PHASES;
    hipLaunchKernelGGL(fwd, dim3(grid), dim3(NTHREADS), LDS_BYTES, stream, a);
#else
    for (int p = 0; p < N_PHASES; ++p) { a.ph_lo = p; a.ph_hi = p + 1; hipLaunchKernelGGL(fwd, dim3(grid), dim3(NTHREADS), LDS_BYTES, stream, a); }
#endif
}
```
